# Optimizing an MI355X kernel written in HIP

```python
import math
import jax, jax.numpy as jnp
from jax import lax
import numpy as np

D_MODEL = 1024
BATCH = 4
SEQ = 8192
DEPTH = 2

HEAD_DIM = 64
ROT_DIM = HEAD_DIM // 4
ROPE_THETA = 500000.0
BLK = 128
NEG_INF = -1e30
EPS = 1e-6
A_HEADS = 8
A_CONFIGS = ((128, 1), (512, 4), (2048, 16))
B_Q_HEADS = 8
B_KV_HEADS = 2
B_GROUP = B_Q_HEADS // B_KV_HEADS
B_WINDOW = 128
C_QK_HEADS = 4
C_V_HEADS = 8
C_DK = 128
C_DV = 128
C_CONV = 4
C_CHUNK = 64
D_FF = 4 * D_MODEL
A_W = A_HEADS * HEAD_DIM
B_QW = B_Q_HEADS * HEAD_DIM
B_KVW = B_KV_HEADS * HEAD_DIM
C_QKW = C_QK_HEADS * C_DK
C_VW = C_V_HEADS * C_DV
IN_WIDTHS = (A_W, A_W, A_W, B_QW, B_KVW, B_KVW, C_QKW, C_QKW, C_VW, C_VW,
             C_V_HEADS, C_V_HEADS, D_MODEL, D_MODEL, D_MODEL)
D_IN = sum(IN_WIDTHS)
MAX_POS_OFFSET = 4096

kernel_name = "hybrid_gated_dilated_swa_deltanet_block"


def rmsnorm(x, gain):
    xf = x.astype(jnp.float32)
    y = xf * lax.rsqrt(jnp.mean(xf * xf, axis=-1, keepdims=True) + EPS)
    return (y * gain.astype(jnp.float32)).astype(x.dtype)


def l2norm(t):
    tf = t.astype(jnp.float32)
    return tf * lax.rsqrt(jnp.sum(tf * tf, axis=-1, keepdims=True) + EPS)


def rope_tables(positions, dtype):
    inv_freq = jnp.power(ROPE_THETA, -jnp.arange(0, ROT_DIM, 2, dtype=jnp.float32) / ROT_DIM)
    ang = positions.astype(jnp.float32)[..., None] * inv_freq
    return jnp.cos(ang)[:, :, None, :].astype(dtype), jnp.sin(ang)[:, :, None, :].astype(dtype)


def apply_rope(x, cos, sin):
    half = ROT_DIM // 2
    x1, x2 = x[..., :half], x[..., half:ROT_DIM]
    return jnp.concatenate([x1 * cos - x2 * sin, x2 * cos + x1 * sin, x[..., ROT_DIM:]], axis=-1)


def split_columns(u):
    outs, start = [], 0
    for width in IN_WIDTHS:
        outs.append(u[..., start:start + width])
        start += width
    return outs


def banded_attention(q, k, v, max_dist, sink=None):
    b, l, hkv, g, d = q.shape
    nb = l // BLK
    qb = q.reshape(b, nb, BLK, hkv, g, d)

    def with_prev(t):
        tb = t.reshape(b, nb, BLK, hkv, d)
        prev = jnp.concatenate([jnp.zeros_like(tb[:, :1]), tb[:, :-1]], axis=1)
        return jnp.concatenate([prev, tb], axis=2)

    kk, vv = with_prev(k), with_prev(v)
    s = jnp.einsum('bnqhgd,bnkhd->bnhgqk', qb, kk,
                   preferred_element_type=jnp.float32) * (d ** -0.5)
    qi = jnp.arange(BLK)[:, None]
    kj = jnp.arange(2 * BLK)[None, :]
    dist = BLK + qi - kj
    band = (dist >= 0) & (dist <= max_dist)
    not_pad = (jnp.arange(nb) > 0)[:, None, None] | (kj >= BLK)[None]
    valid = band[None] & not_pad
    s = jnp.where(valid[None, :, None, None], s, NEG_INF)
    m = jnp.max(s, axis=-1, keepdims=True)
    if sink is not None:
        sk = sink.astype(jnp.float32)[None, None, :, :, None, None]
        m = jnp.maximum(m, sk)
    p = jnp.exp(s - m)
    den = jnp.sum(p, axis=-1, keepdims=True)
    if sink is not None:
        den = den + jnp.exp(sk - m)
    o = jnp.einsum('bnhgqk,bnkhd->bnqhgd', p.astype(v.dtype), vv,
                   preferred_element_type=jnp.float32)
    den_t = jnp.transpose(den[..., 0], (0, 1, 4, 2, 3))
    lse_t = jnp.transpose((m + jnp.log(den))[..., 0], (0, 1, 4, 2, 3))
    o = (o / den_t[..., None]).reshape(b, l, hkv, g, d)
    return o.astype(q.dtype), lse_t.reshape(b, l, hkv, g)


def dilated_attention(q, k, v):
    b, s, h, d = q.shape
    outs, lses = [], []
    for window, dil in A_CONFIGS:
        steps = window // dil
        l = s // dil
        lp = -(-l // BLK) * BLK

        def by_stride(t):
            t = t.reshape(b, l, dil, h, d).transpose(0, 2, 1, 3, 4).reshape(b * dil, l, h, d)
            return jnp.pad(t, ((0, 0), (0, lp - l), (0, 0), (0, 0)))

        o, lse = banded_attention(by_stride(q)[:, :, :, None], by_stride(k), by_stride(v), steps)
        o = o[:, :l, :, 0].reshape(b, dil, l, h, d).transpose(0, 2, 1, 3, 4).reshape(b, s, h, d)
        lse = lse[:, :l, :, 0].reshape(b, dil, l, h).transpose(0, 2, 1, 3).reshape(b, s, h)
        outs.append(o)
        lses.append(lse)
    w = jax.nn.softmax(jnp.stack(lses, axis=0), axis=0)
    o = jnp.sum(w[..., None] * jnp.stack(outs, axis=0).astype(jnp.float32), axis=0)
    return o.astype(q.dtype)


def short_conv(x, w):
    s = x.shape[1]
    xp = jnp.pad(x, ((0, 0), (C_CONV - 1, 0), (0, 0)))
    y = xp[:, 0:s] * w[0]
    for j in range(1, C_CONV):
        y = y + xp[:, j:j + s] * w[j]
    return jax.nn.silu(y)


def gated_delta_rule(q, k, v, g, beta):
    b, s, h, dk = k.shape
    dv = v.shape[-1]
    nc = s // C_CHUNK

    def chunks(t):
        t = t.astype(jnp.float32).reshape((b, nc, C_CHUNK) + t.shape[2:])
        return jnp.moveaxis(t, 3, 1)

    qc = chunks(q) * (dk ** -0.5)
    kc, vc, bc = chunks(k), chunks(v), chunks(beta)
    gc = jnp.cumsum(chunks(g), axis=-1)
    tril = jnp.tril(jnp.ones((C_CHUNK, C_CHUNK), dtype=bool))
    strict = jnp.tril(jnp.ones((C_CHUNK, C_CHUNK), dtype=bool), -1)
    diff = gc[..., :, None] - gc[..., None, :]
    decay = jnp.where(tril, jnp.exp(jnp.where(tril, diff, 0.0)), 0.0)
    kkt = jnp.einsum('bhncd,bhnjd->bhncj', kc, kc)
    a_mat = jnp.where(strict, kkt * decay * bc[..., None], 0.0)
    eye = jnp.eye(C_CHUNK, dtype=jnp.float32)
    rhs = jnp.concatenate([vc * bc[..., None], kc * (bc * jnp.exp(gc))[..., None]], axis=-1)
    sol = lax.linalg.triangular_solve(a_mat + eye, rhs, left_side=True, lower=True,
                                      unit_diagonal=True)
    u, w = sol[..., :dv], sol[..., dv:]
    attn = jnp.where(tril, jnp.einsum('bhncd,bhnjd->bhncj', qc, kc) * decay, 0.0)
    q_dec = qc * jnp.exp(gc)[..., None]
    k_dec = kc * jnp.exp(gc[..., -1:] - gc)[..., None]
    g_last = jnp.exp(gc[..., -1])

    def step(state, xs):
        u_i, w_i, attn_i, qd_i, kd_i, gl_i = xs
        v_new = u_i - jnp.einsum('bhcd,bhde->bhce', w_i, state)
        o_i = (jnp.einsum('bhcd,bhde->bhce', qd_i, state)
               + jnp.einsum('bhcj,bhje->bhce', attn_i, v_new))
        state = state * gl_i[..., None, None] + jnp.einsum('bhcd,bhce->bhde', kd_i, v_new)
        return state, o_i

    xs = tuple(jnp.moveaxis(t, 2, 0) for t in (u, w, attn, q_dec, k_dec, g_last))
    state0 = jnp.zeros((b, h, dk, dv), jnp.float32)
    _, o = lax.scan(step, state0, xs)
    return jnp.transpose(o, (1, 0, 3, 2, 4)).reshape(b, s, h, dv)


def mixer_block(h, cos, sin, w_in, b_in, conv_w, a_log, dt_bias, sinks, c_norm,
                w_branch_a, w_branch_b, w_branch_c, w_out):
    b, s, _ = h.shape
    u = h @ w_in + b_in
    (a_q, a_k, a_v, b_q, b_k, b_v, c_q, c_k, c_v, c_z, c_a, c_b,
     gate_a, gate_b, gate_c) = split_columns(u)

    def heads(t, n):
        return t.reshape(b, s, n, -1)

    ya = dilated_attention(apply_rope(heads(a_q, A_HEADS), cos, sin),
                           apply_rope(heads(a_k, A_HEADS), cos, sin),
                           heads(a_v, A_HEADS)).reshape(b, s, A_W)

    qb = apply_rope(heads(b_q, B_Q_HEADS), cos, sin).reshape(b, s, B_KV_HEADS, B_GROUP, HEAD_DIM)
    kb = apply_rope(heads(b_k, B_KV_HEADS), cos, sin)
    vb = heads(b_v, B_KV_HEADS)
    yb, _ = banded_attention(qb, kb, vb, B_WINDOW - 1, sink=sinks.reshape(B_KV_HEADS, B_GROUP))
    yb = yb.reshape(b, s, B_QW)

    qkv = short_conv(jnp.concatenate([c_q, c_k, c_v], axis=-1), conv_w)
    rep = C_V_HEADS // C_QK_HEADS
    cq = jnp.repeat(l2norm(qkv[..., :C_QKW].reshape(b, s, C_QK_HEADS, C_DK)), rep, axis=2)
    ck = jnp.repeat(l2norm(qkv[..., C_QKW:2 * C_QKW].reshape(b, s, C_QK_HEADS, C_DK)), rep, axis=2)
    cv = qkv[..., 2 * C_QKW:].reshape(b, s, C_V_HEADS, C_DV)
    beta = jax.nn.sigmoid(c_b.astype(jnp.float32))
    g = -jnp.exp(a_log.astype(jnp.float32)) * jax.nn.softplus(
        c_a.astype(jnp.float32) + dt_bias.astype(jnp.float32))
    yc = gated_delta_rule(cq, ck, cv, g, beta)
    yc = rmsnorm(yc, c_norm) * jax.nn.silu(c_z.reshape(b, s, C_V_HEADS, C_DV).astype(jnp.float32))
    yc = yc.astype(h.dtype).reshape(b, s, C_VW)

    merged = (jax.nn.sigmoid(gate_a) * (ya @ w_branch_a)
              + jax.nn.sigmoid(gate_b) * (yb @ w_branch_b)
              + jax.nn.sigmoid(gate_c) * (yc @ w_branch_c))
    return merged @ w_out


def setup_inputs(seed: int = 0) -> dict:
    key = jax.random.key(seed)
    ks = jax.random.split(key, 20)
    f32 = jnp.float32

    def dense(k, shape, fan_in, scale=1.0):
        return jax.random.normal(k, shape, f32) * (scale * fan_in ** -0.5)

    def gain(k, shape):
        return 1.0 + 0.05 * jax.random.normal(k, shape, f32)

    res_scale = (2 * DEPTH) ** -0.5
    x = jax.random.normal(ks[0], (BATCH, SEQ, D_MODEL), f32)
    positions = (jax.random.randint(ks[1], (BATCH, 1), 0, MAX_POS_OFFSET, dtype=jnp.int32)
                 + jnp.arange(SEQ, dtype=jnp.int32)[None, :])
    norm_mix = gain(ks[2], (DEPTH, D_MODEL))
    w_in = dense(ks[3], (DEPTH, D_MODEL, D_IN), D_MODEL)
    b_in = 0.02 * jax.random.normal(ks[4], (DEPTH, D_IN), f32)
    conv_w = dense(ks[5], (DEPTH, C_CONV, 2 * C_QKW + C_VW), C_CONV)
    a_log = jnp.log(jax.random.uniform(ks[6], (DEPTH, C_V_HEADS), f32, 1.0, 16.0))
    dt = jnp.exp(jax.random.uniform(ks[7], (DEPTH, C_V_HEADS), f32, math.log(1e-3), math.log(1e-1)))
    dt_bias = dt + jnp.log(-jnp.expm1(-dt))
    sinks = 0.5 * jax.random.normal(ks[8], (DEPTH, B_Q_HEADS), f32)
    c_norm = gain(ks[9], (DEPTH, C_DV))
    w_branch_a = dense(ks[10], (DEPTH, A_W, D_MODEL), A_W)
    w_branch_b = dense(ks[11], (DEPTH, B_QW, D_MODEL), B_QW)
    w_branch_c = dense(ks[12], (DEPTH, C_VW, D_MODEL), C_VW)
    w_out = dense(ks[13], (DEPTH, D_MODEL, D_MODEL), D_MODEL, res_scale)
    norm_ffn = gain(ks[14], (DEPTH, D_MODEL))
    w_ff1 = dense(ks[15], (DEPTH, D_MODEL, D_FF), D_MODEL)
    w_ff2 = dense(ks[16], (DEPTH, D_FF, D_MODEL), D_FF, res_scale)
    norm_final = gain(ks[17], (D_MODEL,))
    return {"x": x, "positions": positions, "norm_mix": norm_mix, "w_in": w_in, "b_in": b_in,
            "conv_w": conv_w, "a_log": a_log, "dt_bias": dt_bias, "sinks": sinks, "c_norm": c_norm,
            "w_branch_a": w_branch_a, "w_branch_b": w_branch_b, "w_branch_c": w_branch_c,
            "w_out": w_out, "norm_ffn": norm_ffn, "w_ff1": w_ff1, "w_ff2": w_ff2,
            "norm_final": norm_final}


def reference(x, positions, norm_mix, w_in, b_in, conv_w, a_log, dt_bias, sinks, c_norm,
              w_branch_a, w_branch_b, w_branch_c, w_out, norm_ffn, w_ff1, w_ff2, norm_final):
    cos, sin = rope_tables(positions, x.dtype)
    for layer in range(DEPTH):
        h = rmsnorm(x, norm_mix[layer])
        x = x + mixer_block(h, cos, sin, w_in[layer], b_in[layer], conv_w[layer], a_log[layer],
                            dt_bias[layer], sinks[layer], c_norm[layer], w_branch_a[layer],
                            w_branch_b[layer], w_branch_c[layer], w_out[layer])
        h = rmsnorm(x, norm_ffn[layer])
        x = x + jnp.square(jax.nn.relu(h @ w_ff1[layer])) @ w_ff2[layer]
    return rmsnorm(x, norm_final)
```

```cpp
#include <hip/hip_runtime.h>
#include <cstdio>
#include <cstdint>
namespace pg8 {
#define PG8_LAS __attribute__((address_space(3)))
typedef unsigned short bf16_t;
typedef short bf16x8 __attribute__((ext_vector_type(8)));
typedef float f32x4 __attribute__((ext_vector_type(4)));
typedef unsigned u32x4 __attribute__((ext_vector_type(4)));
constexpr int BM = 256, BK = 64, HALF = 128, HTB = HALF * BK * 2  , STAGE_BYTES = 8 * HTB, NXCD = 8, WGM = 8;

__host__ __device__ __forceinline__ int lds_byte(int r, int c) { const int st = (r >> 4) * 2 + (c >> 5), rr = r & 15, cc = c & 31, ob = rr * 64 + cc * 2; return st * 1024 + (ob ^ (((ob >> 9) & 1) << 5)); }
__host__ __device__ __forceinline__ void stage_rc(int b, int& R, int& C) { const int st = b / 1024, sb = b % 1024, swz = sb ^ (((sb >> 9) & 1) << 5); R = (st >> 1) * 16 + swz / 64; C = (st & 1) * 32 + (swz % 64) / 2; }
__host__ __device__ __forceinline__ int perm32(int rho) { const int n = rho >> 4, i = rho & 15; return 8 * (i >> 2) + 4 * n + (i & 3); }

struct Unit { int pm, pn; };
struct Gemm { const bf16_t* A; const bf16_t* Bt; int M, N, K; };

struct StaticOrder {
    int nM, nN, nwg, G, c;
    __host__ __device__ void init(int M, int N, int G_, int c_) { nM = M / BM; nN = N / BM; nwg = nM * nN; G = G_; c = c_; }
    __host__ __device__ bool next(int i, Unit& u) const {
        const long L = (long)i * G + c; if (L >= nwg) return false;
        int wgid = (int)L; { const int q = nwg / NXCD, r = nwg % NXCD, xcd = wgid % NXCD, off = wgid / NXCD; wgid = (xcd < r ? xcd * (q + 1) : r * (q + 1) + (xcd - r) * q) + off; }
        const int nig = WGM * nN, gid = wgid / nig, fm = gid * WGM, gsz = (nM - fm) < WGM ? (nM - fm) : WGM;
        u.pm = fm + ((wgid % nig) % gsz); u.pn = (wgid % nig) / gsz; return true;
    }
    __device__ __forceinline__ void a_ready(const Unit&) const {}
    __device__ __forceinline__ void done(const Unit&) const {}
};

__device__ __forceinline__ unsigned cvt_pk_bf16(float lo, float hi) { unsigned r; asm volatile("v_cvt_pk_bf16_f32 %0, %1, %2" : "=v"(r) : "v"(lo), "v"(hi)); return r; }
typedef float f32x2 __attribute__((ext_vector_type(2)));
__device__ __forceinline__ f32x2 gelu_pk(f32x2 v) {
    const f32x2 av = __builtin_elementwise_abs(v), d = av * 0.2316418882f + 1.0f;
    f32x2 t; t.x = __builtin_amdgcn_rcpf(d.x); t.y = __builtin_amdgcn_rcpf(d.y);
    f32x2 q = t * 0.5307027145f + (-0.7265760135f); q = q * t + 0.7107068705f; q = q * t + (-0.142248368f); q = q * t + 0.127414796f; q = q * t;
    const f32x2 s = (v * v) * (-0.72134752044f);
    f32x2 e; e.x = __builtin_amdgcn_exp2f(s.x); e.y = __builtin_amdgcn_exp2f(s.y);
    const f32x2 m = v * (q * e), r = v - m;
    f32x2 o; o.x = v.x < 0.f ? m.x : r.x; o.y = v.y < 0.f ? m.y : r.y; return o;
}

template <int ACT  > struct EpiBf16 {
    static constexpr bool PERM = true, AFTER_DRAIN = false; static_assert(ACT == 0 || ACT == 1, "EpiBf16: ACT is 0 (none) or 1 (gelu_pk)");
    bf16_t* O; int ldc; const float* bias; int split_cols; size_t split_stride; float scale0;
    __device__ __forceinline__ void operator()(const f32x4 (&acc)[2][2][4][2], const Unit& u, int wr, int wc, int fr, int fq) const {
        const int row0 = u.pm * BM + wr * 64 + fr; int colt = u.pn * BM; bf16_t* base = O;
        float sc = 1.f; if (split_cols) { const int t = colt / split_cols; base += (size_t)t * split_stride; colt -= t * split_cols; if (t == 0) sc = scale0; }
        const int col0 = colt + wc * 32 + 8 * fq, bcol0 = u.pn * BM + wc * 32 + 8 * fq;
        f32x4 bv[2][2];
#pragma unroll
        for (int bj = 0; bj < 2; ++bj)
#pragma unroll
            for (int n = 0; n < 2; ++n) bv[bj][n] = bias ? *(const f32x4*)(bias + bcol0 + bj * HALF + 4 * n) : (f32x4){0.f, 0.f, 0.f, 0.f};
#pragma unroll
        for (int ai = 0; ai < 2; ++ai)
#pragma unroll
            for (int m = 0; m < 4; ++m) { bf16_t* rowp = base + (size_t)(row0 + ai * HALF + m * 16) * ldc + col0;
#pragma unroll
                for (int bj = 0; bj < 2; ++bj) { f32x4 v0 = acc[ai][bj][m][0] + bv[bj][0], v1 = acc[ai][bj][m][1] + bv[bj][1];
                    if (ACT == 1) { f32x2 a = gelu_pk((f32x2){v0[0], v0[1]}), b = gelu_pk((f32x2){v0[2], v0[3]}), c = gelu_pk((f32x2){v1[0], v1[1]}), d = gelu_pk((f32x2){v1[2], v1[3]});
                        v0 = (f32x4){a.x, a.y, b.x, b.y}; v1 = (f32x4){c.x, c.y, d.x, d.y}; }
                    v0 = v0 * sc; v1 = v1 * sc; u32x4 w; w.x = cvt_pk_bf16(v0[0], v0[1]); w.y = cvt_pk_bf16(v0[2], v0[3]); w.z = cvt_pk_bf16(v1[0], v1[1]); w.w = cvt_pk_bf16(v1[2], v1[3]);
                    *(u32x4*)(rowp + bj * HALF) = w; } }
    }
};
template <class Epi, class Sched, bool ALIGN_EPI = false, bool SP2 = false>
__device__ __forceinline__ void gemm_phase(PG8_LAS unsigned char* lds, const Gemm g, const Sched& S, const Epi& E) {
    int tid_l = threadIdx.x; asm volatile("" : "+v"(tid_l));
    const int tid = tid_l, wid = __builtin_amdgcn_readfirstlane(tid >> 6), lane = tid & 63, wr = wid >> 2, wc = wid & 3, fr = lane & 15, fq = lane >> 4;
    const int K = g.K, nt = K / BK;
    unsigned voffA[2], voffB[2];
#pragma unroll
    for (int i = 0; i < 2; ++i) { int R, C; stage_rc(tid * 16 + i * 8192, R, C); const int Rb = Epi::PERM ? ((R & ~31) + perm32(R & 31)) : R;
        voffA[i] = (unsigned)(R * K + C) * 2u; voffB[i] = (unsigned)(Rb * K + C) * 2u; }
    const size_t kstep = (size_t)(BK * 2);
    const size_t hstep = (size_t)HALF * K * 2;
    const size_t tstep = 2 * hstep;
    const unsigned ldsw = (unsigned)wid * 1024u;
    const int aoff = lds_byte(wr * 64 + fr, fq * 8), boff = lds_byte(wc * 32 + fr, fq * 8);
#define PG8_SA(b, h) (((b) * 2 + (h)) * HTB)
#define PG8_SB(b, h) ((4 + (b) * 2 + (h)) * HTB)
#define PG8_STAGE(bufoff, gbase, voff) do { _Pragma("unroll") for (int _i = 0; _i < 2; ++_i) \
        __builtin_amdgcn_global_load_lds((const unsigned*)((const char*)(gbase) + (voff)[_i]), (PG8_LAS unsigned*)(lds + (bufoff) + ldsw + _i * 8192), 16, 0, 0); } while (0)
#define PG8_LDA(dst, b, h) do { _Pragma("unroll") for (int m = 0; m < 4; ++m) _Pragma("unroll") for (int k = 0; k < 2; ++k) dst[m][k] = *(const PG8_LAS bf16x8*)(lds + PG8_SA(b, h) + aoff + m * 2048 + k * 1024); } while (0)
#define PG8_LDB(dst, b, h) do { _Pragma("unroll") for (int n = 0; n < 2; ++n) _Pragma("unroll") for (int k = 0; k < 2; ++k) dst[n][k] = *(const PG8_LAS bf16x8*)(lds + PG8_SB(b, h) + boff + n * 2048 + k * 1024); } while (0)
#define PG8_MMA(ai, bj, At, Bt) do { __builtin_amdgcn_s_setprio(1); _Pragma("unroll") for (int m = 0; m < 4; ++m) _Pragma("unroll") for (int n = 0; n < 2; ++n) _Pragma("unroll") for (int k = 0; k < 2; ++k) \
        acc[ai][bj][m][n] = __builtin_amdgcn_mfma_f32_16x16x32_bf16(Bt[n][k], At[m][k], acc[ai][bj][m][n], 0, 0, 0); __builtin_amdgcn_s_setprio(0); } while (0)
#define PG8_WAIT_V(n) asm volatile("s_waitcnt vmcnt(" #n ")" ::: "memory")
#define PG8_WAIT_L(n) asm volatile("s_waitcnt lgkmcnt(" #n ")" ::: "memory")
#define PG8_BAR __builtin_amdgcn_s_barrier()
#define PG8_SCHED __builtin_amdgcn_sched_barrier(0)
    Unit cur, nxt; int ui = 0;
    if (!S.next(0, cur)) return;
    f32x4 acc[2][2][4][2];
#pragma unroll
    for (int a = 0; a < 2; ++a)
#pragma unroll
        for (int b = 0; b < 2; ++b)
#pragma unroll
            for (int m = 0; m < 4; ++m)
#pragma unroll
                for (int n = 0; n < 2; ++n) acc[a][b][m][n] = (f32x4){0.f, 0.f, 0.f, 0.f};
    bf16x8 At[4][2], B0[2][2], B1[2][2];
    const char* cA = (const char*)g.A + (size_t)cur.pm * tstep; const char* cB = (const char*)g.Bt + (size_t)cur.pn * tstep;
    S.a_ready(cur);
    if constexpr (SP2) {
        PG8_STAGE(PG8_SB(0, 0), cB, voffB); PG8_STAGE(PG8_SB(0, 1), cB + hstep, voffB); PG8_STAGE(PG8_SA(0, 0), cA, voffA); PG8_STAGE(PG8_SA(0, 1), cA + hstep, voffA);
        if (wr == 1) PG8_BAR;
        PG8_WAIT_V(2); PG8_BAR;
        PG8_STAGE(PG8_SB(1, 0), cB + kstep, voffB); PG8_STAGE(PG8_SA(1, 0), cA + kstep, voffA); PG8_STAGE(PG8_SB(1, 1), cB + hstep + kstep, voffB);
        PG8_WAIT_V(6); PG8_BAR;
    } else {
        PG8_STAGE(PG8_SB(0, 0), cB, voffB); PG8_STAGE(PG8_SA(0, 0), cA, voffA); PG8_STAGE(PG8_SB(0, 1), cB + hstep, voffB); PG8_STAGE(PG8_SA(0, 1), cA + hstep, voffA);
        if (wr == 1) PG8_BAR;
        PG8_WAIT_V(4); PG8_BAR;
        PG8_STAGE(PG8_SB(1, 0), cB + kstep, voffB); PG8_STAGE(PG8_SA(1, 0), cA + kstep, voffA); PG8_STAGE(PG8_SB(1, 1), cB + hstep + kstep, voffB);
        PG8_WAIT_V(6); PG8_BAR;
    }
    for (;;) {
        const bool has_next = S.next(ui + 1, nxt);
        const char* nA = has_next ? (const char*)g.A + (size_t)nxt.pm * tstep : cA; const char* nB = has_next ? (const char*)g.Bt + (size_t)nxt.pn * tstep : cB;
        for (int t = 0; t < nt; t += 2) {
            const bool last = (t == nt - 2);
            const char* a1 = cA + (size_t)(t + 1) * kstep;
            const char* a2 = last ? nA : cA + (size_t)(t + 2) * kstep; const char* b2 = last ? nB : cB + (size_t)(t + 2) * kstep;
            const char* a3 = a2 + kstep; const char* b3 = b2 + kstep;
            if (last && has_next) S.a_ready(nxt);
            if constexpr (SP2) {
            PG8_LDB(B0, 0, 0); PG8_LDB(B1, 0, 1); PG8_SCHED; PG8_LDA(At, 0, 0); PG8_STAGE(PG8_SA(1, 1), a1 + hstep, voffA);
            PG8_WAIT_V(8); PG8_WAIT_L(0); PG8_BAR; PG8_MMA(0, 0, At, B0); PG8_MMA(0, 1, At, B1); PG8_BAR; PG8_SCHED;
            PG8_LDA(At, 0, 1); PG8_STAGE(PG8_SB(0, 0), b2, voffB); PG8_STAGE(PG8_SB(0, 1), b2 + hstep, voffB); PG8_STAGE(PG8_SA(0, 0), a2, voffA);
            PG8_WAIT_V(8); PG8_WAIT_L(0); PG8_BAR; PG8_MMA(1, 0, At, B0); PG8_MMA(1, 1, At, B1); PG8_BAR; PG8_SCHED;
            PG8_LDB(B0, 1, 0); PG8_LDB(B1, 1, 1); PG8_SCHED; PG8_LDA(At, 1, 0); PG8_STAGE(PG8_SA(0, 1), a2 + hstep, voffA);
            PG8_WAIT_V(8); PG8_WAIT_L(0); PG8_BAR; PG8_MMA(0, 0, At, B0); PG8_MMA(0, 1, At, B1); PG8_BAR; PG8_SCHED;
            PG8_LDA(At, 1, 1); PG8_STAGE(PG8_SB(1, 0), b3, voffB); PG8_STAGE(PG8_SB(1, 1), b3 + hstep, voffB); PG8_STAGE(PG8_SA(1, 0), a3, voffA);
            PG8_WAIT_V(8); PG8_WAIT_L(0); PG8_BAR; PG8_MMA(1, 0, At, B0); PG8_MMA(1, 1, At, B1); PG8_BAR; PG8_SCHED;
            } else {
            PG8_LDB(B0, 0, 0); PG8_SCHED; PG8_LDA(At, 0, 0); PG8_STAGE(PG8_SA(1, 1), a1 + hstep, voffA);
            PG8_WAIT_L(8); PG8_BAR; PG8_WAIT_L(0); PG8_MMA(0, 0, At, B0); PG8_BAR; PG8_SCHED;
            PG8_LDB(B1, 0, 1); PG8_STAGE(PG8_SB(0, 0), b2, voffB);
            PG8_BAR; PG8_WAIT_L(0); PG8_MMA(0, 1, At, B1); PG8_BAR;
            PG8_LDA(At, 0, 1); PG8_STAGE(PG8_SA(0, 0), a2, voffA);
            PG8_BAR; PG8_WAIT_L(0); PG8_MMA(1, 0, At, B0); PG8_BAR; PG8_SCHED;
            PG8_STAGE(PG8_SB(0, 1), b2 + hstep, voffB);
            PG8_WAIT_V(6); PG8_BAR; PG8_MMA(1, 1, At, B1); PG8_BAR;
            PG8_LDB(B0, 1, 0); PG8_SCHED; PG8_LDA(At, 1, 0); PG8_STAGE(PG8_SA(0, 1), a2 + hstep, voffA);
            PG8_WAIT_L(8); PG8_BAR; PG8_WAIT_L(0); PG8_MMA(0, 0, At, B0); PG8_BAR; PG8_SCHED;
            PG8_LDB(B1, 1, 1); PG8_STAGE(PG8_SB(1, 0), b3, voffB);
            PG8_BAR; PG8_WAIT_L(0); PG8_MMA(0, 1, At, B1); PG8_BAR;
            PG8_LDA(At, 1, 1); PG8_STAGE(PG8_SA(1, 0), a3, voffA);
            PG8_BAR; PG8_WAIT_L(0); PG8_MMA(1, 0, At, B0); PG8_BAR; PG8_SCHED;
            PG8_STAGE(PG8_SB(1, 1), b3 + hstep, voffB);
            PG8_WAIT_V(6); PG8_BAR; PG8_MMA(1, 1, At, B1); PG8_BAR;
            }
        }
        if constexpr (ALIGN_EPI) { if (wr == 0) PG8_BAR; }
        if constexpr (!Epi::AFTER_DRAIN) { E(acc, cur, wr, wc, fr, fq); S.done(cur); }
        if (!has_next) break;
#pragma unroll
        for (int a = 0; a < 2; ++a)
#pragma unroll
            for (int b = 0; b < 2; ++b)
#pragma unroll
                for (int m = 0; m < 4; ++m)
#pragma unroll
                    for (int n = 0; n < 2; ++n) acc[a][b][m][n] = (f32x4){0.f, 0.f, 0.f, 0.f};
        cur = nxt; cA = nA; cB = nB; ++ui;
        if constexpr (ALIGN_EPI) { if (wr == 1) PG8_BAR; }
    }
    PG8_WAIT_V(0);
    if constexpr (!ALIGN_EPI) { if (wr == 0) PG8_BAR; }
    PG8_BAR;
    if constexpr (Epi::AFTER_DRAIN) { E.fused(acc, cur, wr, wc, fr, fq, lds, wid, lane); S.done(cur); }
#undef PG8_SA
#undef PG8_SB
#undef PG8_STAGE
#undef PG8_LDA
#undef PG8_LDB
#undef PG8_MMA
#undef PG8_WAIT_V
#undef PG8_WAIT_L
#undef PG8_BAR
#undef PG8_SCHED
}
}

#include <hip/hip_cooperative_groups.h>
namespace cg = cooperative_groups;
using pg8::bf16_t; using pg8::bf16x8; using pg8::f32x4; using pg8::u32x4; using pg8::Unit; using pg8::BM; using pg8::HALF;
#define LAS __attribute__((address_space(3)))
typedef unsigned u32x2 __attribute__((ext_vector_type(2)));
#define GAS __attribute__((address_space(1)))
#define GP(p) ((GAS __typeof__(*(p))*)(p))
__device__ __forceinline__ GAS unsigned char* opq(unsigned char* p) { asm volatile("" : "+s"(p)); return (GAS unsigned char*)p; }

typedef float f32x2_t __attribute__((ext_vector_type(2))); typedef __bf16 bf16x2_t __attribute__((ext_vector_type(2)));
__device__ __forceinline__ unsigned pkbf(float lo, float hi) { f32x2_t v = {lo, hi}; bf16x2_t b = __builtin_convertvector(v, bf16x2_t); return __builtin_bit_cast(unsigned, b); }

constexpr int D_MODEL = 1024, BATCH = 4, SEQ = 8192, DEPTH = 2, M = BATCH * SEQ;
constexpr int NSPLIT = 2, MH = M / NSPLIT, BPH = BATCH / NSPLIT;
constexpr int D_IN = 8464, N_MAIN = 5392, N_MAIN_PAD = 5632, D_FF = 4096;
constexpr float EPS = 1e-6f, LOG2E = 1.4426950408889634f, QSCALE = 0.125f * LOG2E;
constexpr int NTH = 512;

constexpr size_t MiB = 1u << 20;
constexpr size_t WS_CTL = 0, CTL_BYTES = 1 * MiB;
constexpr size_t WS_SS = 488 * MiB;
constexpr size_t WS_CS = 1 * MiB;
constexpr size_t WS_WIN = 3 * MiB, WS_WG = 14 * MiB, WS_WA = 20 * MiB, WS_WB = 21 * MiB, WS_WC = 22 * MiB, WS_WO = 24 * MiB, WS_W1 = 26 * MiB, WS_W2 = 34 * MiB;
constexpr size_t WS_XB = 44 * MiB;
constexpr size_t WS_UA = 108 * MiB, WS_UC = 180 * MiB, WS_UZ = 244 * MiB, WS_UAB = 276 * MiB, WS_GL = 277 * MiB, WS_LSE = 278 * MiB;
constexpr size_t WS_W = 280 * MiB, WS_QD = 312 * MiB, WS_KDT = 344 * MiB, WS_UT = 376 * MiB, WS_ATT = 408 * MiB, WS_YAP = 424 * MiB, WS_YB = 472 * MiB, WS_END = 498 * MiB;
constexpr size_t WS_O = WS_UC, WS_YA = WS_W, WS_YC = WS_QD, WS_MRG = WS_KDT, WS_GA = 108 * MiB, WS_GB = 140 * MiB  , WS_GC = WS_UT  , WS_MSCR = 204 * MiB  , WS_H1 = WS_UA;

struct Args {
    const float* x; const int* pos; const float* norm_mix; const float* w_in; const float* b_in; const float* conv_w; const float* a_log; const float* dt_bias;
    const float* sinks; const float* c_norm; const float* wba; const float* wbb; const float* wbc; const float* w_out; const float* norm_ffn; const float* w_ff1;
    const float* w_ff2; const float* norm_final; float* out; unsigned char* ws;
};

__device__ __forceinline__ float bf_lo(unsigned u) { return __uint_as_float(u << 16); }
__device__ __forceinline__ float bf_hi(unsigned u) { return __uint_as_float(u & 0xffff0000u); }
__device__ __forceinline__ float sigmoidf_(float v) { return 1.0f / (1.0f + __expf(-v)); }
__device__ __forceinline__ f32x4 mfma16(bf16x8 a, bf16x8 b, f32x4 c) { return __builtin_amdgcn_mfma_f32_16x16x32_bf16(a, b, c, 0, 0, 0); }

__device__ __forceinline__ float row_rstd(GAS const float* ssp, int r) {
    GAS const f32x4* p = (GAS const f32x4*)(ssp + (size_t)r * 16); const f32x4 a = p[0], b = p[1], c = p[2], d = p[3];
    const float t = (((a[0] + a[1]) + (a[2] + a[3])) + ((b[0] + b[1]) + (b[2] + b[3]))) + (((c[0] + c[1]) + (c[2] + c[3])) + ((d[0] + d[1]) + (d[2] + d[3])));
    return rsqrtf(t * (1.0f / D_MODEL) + EPS);
}
struct EpiG1 {
    static constexpr bool PERM = true, AFTER_DRAIN = false;
    GAS bf16_t*UA, *UC, *UZ; GAS float* UAB; GAS const float* bias; GAS const float* ss; GAS const float* cs;
    __device__ __forceinline__ void operator()(const f32x4 (&acc)[2][2][4][2], const Unit& u, int wr, int wc, int fr_in, int fq) const {
        int fr = fr_in; asm volatile("" : "+v"(fr));
        const int pn = u.pn; const int row0 = u.pm * BM + wr * 64 + fr; const int bcol0 = pn * BM + wc * 32 + 8 * fq;
        f32x4 bv[2][2];
#pragma unroll
        for (int bj = 0; bj < 2; ++bj)
#pragma unroll
            for (int n = 0; n < 2; ++n) bv[bj][n] = *(GAS const f32x4*)(bias + bcol0 + bj * HALF + 4 * n);
        if (pn == 21) {
            if (wc == 0 && fq < 2) {
#pragma unroll
                for (int ai = 0; ai < 2; ++ai)
#pragma unroll
                    for (int m = 0; m < 4; ++m) { const int r = row0 + ai * HALF + m * 16; const float rs = row_rstd(ss, r);
                        *(GAS f32x4*)(UAB + (size_t)r * 16 + 8 * fq) = acc[ai][0][m][0] * rs + bv[0][0]; *(GAS f32x4*)(UAB + (size_t)r * 16 + 8 * fq + 4) = acc[ai][0][m][1] * rs + bv[0][1]; }
            }
            return;
        }
        GAS bf16_t* base; int ldc, colt;
        if (pn < 9) { base = UA; ldc = 2304; colt = pn * 256; } else if (pn < 17) { base = UC; ldc = 2048; colt = (pn - 9) * 256; } else { base = UZ; ldc = 1024; colt = (pn - 17) * 256; }
        const int col0 = colt + wc * 32 + 8 * fq;
        const float qs = (pn < 2 || pn == 6 || pn == 7) ? QSCALE : 1.0f;
        const float sg = (fq == 0) ? -1.0f : 1.0f;
#pragma unroll
        for (int ai = 0; ai < 2; ++ai)
#pragma unroll
            for (int m = 0; m < 4; ++m) { const int r = row0 + ai * HALF + m * 16; const float rs = row_rstd(ss, r);
                GAS bf16_t* rowp = base + (size_t)r * ldc + col0;
#pragma unroll
                for (int bj = 0; bj < 2; ++bj) { f32x4 v0 = acc[ai][bj][m][0] * rs + bv[bj][0], v1 = acc[ai][bj][m][1] * rs + bv[bj][1];
                    const bool rope = ((wc & 1) == 0) && (pn < 4 || pn == 6 || pn == 7 || (pn == 8 && bj == 0));
                    if (rope) { f32x4 p0, p1;
#pragma unroll
                        for (int i = 0; i < 4; ++i) { p0[i] = __shfl_xor(v0[i], 16); p1[i] = __shfl_xor(v1[i], 16); }
                        if (fq < 2) { GAS const float* c = cs + (size_t)r * 16; const f32x4 c0 = *(GAS const f32x4*)c, c1 = *(GAS const f32x4*)(c + 4), s0 = *(GAS const f32x4*)(c + 8), s1 = *(GAS const f32x4*)(c + 12);
                            v0 = v0 * c0 + (p0 * s0) * sg; v1 = v1 * c1 + (p1 * s1) * sg; } }
                    v0 = v0 * qs; v1 = v1 * qs; u32x4 w; w.x = pkbf(v0[0], v0[1]); w.y = pkbf(v0[2], v0[3]); w.z = pkbf(v1[0], v1[1]); w.w = pkbf(v1[2], v1[3]);
                    *(GAS u32x4*)(rowp + bj * HALF) = w; }
                asm volatile("" ::: "memory"); }
    }
};
struct EpiGate {
    static constexpr bool PERM = true, AFTER_DRAIN = false;
    GAS bf16_t* O0; GAS const float* bias; GAS const float* ss;
    __device__ __forceinline__ void operator()(const f32x4 (&acc)[2][2][4][2], const Unit& u, int wr, int wc, int fr_in, int fq) const {
        int fr = fr_in; asm volatile("" : "+v"(fr));
        const int row0 = u.pm * BM + wr * 64 + fr; const int col0 = u.pn * BM + wc * 32 + 8 * fq; const int tb = u.pn >> 2; const int lcol0 = col0 - tb * 1024;
        GAS bf16_t* O = O0 + ((tb == 0) ? (size_t)0 : (tb == 1) ? (size_t)((WS_GB - WS_GA) / 2) : (size_t)((WS_GC - WS_GA) / 2));
        f32x4 bv[2][2];
#pragma unroll
        for (int bj = 0; bj < 2; ++bj)
#pragma unroll
            for (int n = 0; n < 2; ++n) bv[bj][n] = *(GAS const f32x4*)(bias + col0 + bj * HALF + 4 * n);
#pragma unroll
        for (int ai = 0; ai < 2; ++ai)
#pragma unroll
            for (int m = 0; m < 4; ++m) { const int r = row0 + ai * HALF + m * 16; const float rs = row_rstd(ss, r);
#pragma unroll
                for (int bj = 0; bj < 2; ++bj) { const f32x4 v0 = acc[ai][bj][m][0] * rs + bv[bj][0], v1 = acc[ai][bj][m][1] * rs + bv[bj][1]; u32x4 w;
                    w.x = pkbf(sigmoidf_(v0[0]), sigmoidf_(v0[1])); w.y = pkbf(sigmoidf_(v0[2]), sigmoidf_(v0[3]));
                    w.z = pkbf(sigmoidf_(v1[0]), sigmoidf_(v1[1])); w.w = pkbf(sigmoidf_(v1[2]), sigmoidf_(v1[3]));
                    *(GAS u32x4*)(O + (size_t)r * 1024 + lcol0 + bj * HALF) = w; }
                asm volatile("" ::: "memory"); }
    }
};
template <int MODE> struct EpiBranch {
    static constexpr bool PERM = true, AFTER_DRAIN = false;
    GAS const bf16_t* gates; GAS f32x4* mscr; GAS bf16_t* out;
    __device__ __forceinline__ void operator()(const f32x4 (&acc)[2][2][4][2], const Unit& u, int wr, int wc, int fr_in, int fq) const {
        int fr = fr_in; asm volatile("" : "+v"(fr));
        const int row0 = u.pm * BM + wr * 64 + fr; const int col0 = u.pn * BM + wc * 32 + 8 * fq; const int tid = (wr * 4 + wc) * 64 + fq * 16 + fr;
        GAS f32x4* ms = mscr + tid;
#pragma unroll
        for (int ai = 0; ai < 2; ++ai)
#pragma unroll
            for (int m = 0; m < 4; ++m) { const int r = row0 + ai * HALF + m * 16;
#pragma unroll
                for (int bj = 0; bj < 2; ++bj) { const u32x4 g = *(GAS const u32x4*)(gates + (size_t)r * 1024 + col0 + bj * HALF);
                    f32x4 v0 = acc[ai][bj][m][0] * (f32x4){bf_lo(g.x), bf_hi(g.x), bf_lo(g.y), bf_hi(g.y)}, v1 = acc[ai][bj][m][1] * (f32x4){bf_lo(g.z), bf_hi(g.z), bf_lo(g.w), bf_hi(g.w)};
                    if (MODE == 0) { ms[0] = v0; ms[NTH] = v1; }
                    else if (MODE == 1) { ms[0] = ms[0] + v0; ms[NTH] = ms[NTH] + v1; }
                    else { v0 = v0 + ms[0]; v1 = v1 + ms[NTH]; u32x4 w; w.x = pkbf(v0[0], v0[1]); w.y = pkbf(v0[2], v0[3]); w.z = pkbf(v1[0], v1[1]); w.w = pkbf(v1[2], v1[3]);
                        *(GAS u32x4*)(out + (size_t)r * D_MODEL + col0 + bj * HALF) = w; }
                    ms += 2 * NTH; asm volatile("" : "+v"(ms)); }
                asm volatile("" ::: "memory"); }
    }
};
struct EpiResid {
    static constexpr bool PERM = true, AFTER_DRAIN = false;
    GAS const float* base; GAS float* out; GAS bf16_t* xb; GAS float* ssout;
    __device__ __forceinline__ void operator()(const f32x4 (&acc)[2][2][4][2], const Unit& u, int wr, int wc, int fr_in, int fq) const {
        int fr = fr_in; asm volatile("" : "+v"(fr));
        const int row0 = u.pm * BM + wr * 64 + fr; const int col0 = u.pn * BM + wc * 32 + 8 * fq;
#pragma unroll
        for (int ai = 0; ai < 2; ++ai)
#pragma unroll
            for (int m = 0; m < 4; ++m) { const int r = row0 + ai * HALF + m * 16; float sq = 0.f;
#pragma unroll
                for (int bj = 0; bj < 2; ++bj) { const size_t off = (size_t)r * D_MODEL + col0 + bj * HALF;
                    const f32x4 v0 = acc[ai][bj][m][0] + *(GAS const f32x4*)(base + off), v1 = acc[ai][bj][m][1] + *(GAS const f32x4*)(base + off + 4);
                    *(GAS f32x4*)(out + off) = v0; *(GAS f32x4*)(out + off + 4) = v1;
                    u32x4 w; w.x = pkbf(v0[0], v0[1]); w.y = pkbf(v0[2], v0[3]); w.z = pkbf(v1[0], v1[1]); w.w = pkbf(v1[2], v1[3]);
                    *(GAS u32x4*)(xb + off) = w;
                    sq += (v0[0] * v0[0] + v0[1] * v0[1]) + (v0[2] * v0[2] + v0[3] * v0[3]) + (v1[0] * v1[0] + v1[1] * v1[1]) + (v1[2] * v1[2] + v1[3] * v1[3]); }
                sq += __shfl_xor(sq, 16); sq += __shfl_xor(sq, 32);
                if (fq == 0) ssout[(size_t)r * 16 + u.pn * 4 + wc] = sq;
                asm volatile("" ::: "memory"); }
    }
};
struct EpiRelu2 {
    static constexpr bool PERM = true, AFTER_DRAIN = false;
    GAS bf16_t* O; GAS const float* ss;
    __device__ __forceinline__ void operator()(const f32x4 (&acc)[2][2][4][2], const Unit& u, int wr, int wc, int fr_in, int fq) const {
        int fr = fr_in; asm volatile("" : "+v"(fr));
        const int row0 = u.pm * BM + wr * 64 + fr; const int col0 = u.pn * BM + wc * 32 + 8 * fq;
#pragma unroll
        for (int ai = 0; ai < 2; ++ai)
#pragma unroll
            for (int m = 0; m < 4; ++m) { const int r = row0 + ai * HALF + m * 16; const float rs = row_rstd(ss, r);
#pragma unroll
                for (int bj = 0; bj < 2; ++bj) { f32x4 v0 = acc[ai][bj][m][0] * rs, v1 = acc[ai][bj][m][1] * rs;
#pragma unroll
                    for (int i = 0; i < 4; ++i) { const float a = fmaxf(v0[i], 0.f), b = fmaxf(v1[i], 0.f); v0[i] = a * a; v1[i] = b * b; }
                    u32x4 w; w.x = pkbf(v0[0], v0[1]); w.y = pkbf(v0[2], v0[3]); w.z = pkbf(v1[0], v1[1]); w.w = pkbf(v1[2], v1[3]);
                    *(GAS u32x4*)(O + (size_t)r * D_FF + col0 + bj * HALF) = w; }
                asm volatile("" ::: "memory"); }
    }
};

__device__ __forceinline__ void transpose_item(GAS const float* W, int K, int ldw, int c0, int ncols, GAS const float* gain, GAS bf16_t* WT, LAS float* scr, int item, int lane) {
    const int nblk = (ncols + 31) / 32, kb = item / nblk, nb = item % nblk, k0 = 64 * kb, n0 = 32 * nb;
    const bool ok = (n0 + (lane & 31)) < ncols;
#pragma unroll 8
    for (int i = 0; i < 32; ++i) { const int kk = 2 * i + (lane >> 5); float v = 0.f; if (ok) { v = W[(size_t)(k0 + kk) * ldw + c0 + n0 + (lane & 31)]; if (gain) v *= gain[k0 + kk]; } scr[kk * 33 + (lane & 31)] = v; }
    asm volatile("s_waitcnt lgkmcnt(0)" ::: "memory");
    const int c = lane & 7;
#pragma unroll
    for (int j = 0; j < 4; ++j) { const int n = (lane >> 3) + 8 * j; const LAS float* s = scr + (8 * c) * 33 + n; u32x4 o;
        o.x = pkbf(s[0 * 33], s[1 * 33]); o.y = pkbf(s[2 * 33], s[3 * 33]); o.z = pkbf(s[4 * 33], s[5 * 33]); o.w = pkbf(s[6 * 33], s[7 * 33]);
        *(GAS u32x4*)(WT + (size_t)(n0 + n) * K + k0 + 8 * c) = o; }
    asm volatile("s_waitcnt lgkmcnt(0)" ::: "memory");
}
__device__ __forceinline__ void convert_weights(const Args& a, int layer, LAS unsigned char* lds, int gw, int ngw, int wave, int lane) {
    LAS float* scr = (LAS float*)(lds + wave * 8448);
    GAS unsigned char* ws = opq(a.ws);
    GAS const float* win = GP(a.w_in) + (size_t)layer * D_MODEL * D_IN; GAS const float* gmix = GP(a.norm_mix) + layer * D_MODEL; GAS const float* gffn = GP(a.norm_ffn) + layer * D_MODEL;
    constexpr int I_MAIN = 16 * 169, I_G = 16 * 96, I_A = 8 * 32, I_C = 16 * 32, I_1 = 16 * 128, I_2 = 64 * 32;
    constexpr int TOT = I_MAIN + I_G + 2 * I_A + 2 * I_C + I_1 + I_2;
    for (int it = gw; it < TOT; it += ngw) { int r = it;
        if (r < I_MAIN) { transpose_item(win, 1024, D_IN, 0, N_MAIN, gmix, (GAS bf16_t*)(ws + WS_WIN), scr, r, lane); continue; } r -= I_MAIN;
        if (r < I_G) { transpose_item(win, 1024, D_IN, N_MAIN, 3072, gmix, (GAS bf16_t*)(ws + WS_WG), scr, r, lane); continue; } r -= I_G;
        if (r < I_A) { transpose_item(GP(a.wba) + (size_t)layer * 512 * 1024, 512, 1024, 0, 1024, nullptr, (GAS bf16_t*)(ws + WS_WA), scr, r, lane); continue; } r -= I_A;
        if (r < I_A) { transpose_item(GP(a.wbb) + (size_t)layer * 512 * 1024, 512, 1024, 0, 1024, nullptr, (GAS bf16_t*)(ws + WS_WB), scr, r, lane); continue; } r -= I_A;
        if (r < I_C) { transpose_item(GP(a.wbc) + (size_t)layer * 1024 * 1024, 1024, 1024, 0, 1024, nullptr, (GAS bf16_t*)(ws + WS_WC), scr, r, lane); continue; } r -= I_C;
        if (r < I_C) { transpose_item(GP(a.w_out) + (size_t)layer * 1024 * 1024, 1024, 1024, 0, 1024, nullptr, (GAS bf16_t*)(ws + WS_WO), scr, r, lane); continue; } r -= I_C;
        if (r < I_1) { transpose_item(GP(a.w_ff1) + (size_t)layer * 1024 * 4096, 1024, 4096, 0, 4096, gffn, (GAS bf16_t*)(ws + WS_W1), scr, r, lane); continue; } r -= I_1;
        transpose_item(GP(a.w_ff2) + (size_t)layer * 4096 * 1024, 4096, 1024, 0, 1024, nullptr, (GAS bf16_t*)(ws + WS_W2), scr, r, lane);
    }
    { GAS u32x4* z = (GAS u32x4*)((GAS bf16_t*)(ws + WS_WIN) + (size_t)5408 * 1024); const int nz = (N_MAIN_PAD - 5408) * 1024 / 8;
      for (int i = gw * 64 + lane; i < nz; i += ngw * 64) z[i] = (u32x4){0u, 0u, 0u, 0u}; }
}

typedef short v4i16_t __attribute__((ext_vector_type(4)));
struct AttnRegs { u32x4 k[4], v[4]; bf16x8 q0, q1; };
struct AttnDesc { int cfg, bl, head, lg, res, nb, qcol, kcol, vcol; };
__device__ __forceinline__ AttnDesc attn_desc(int uid) {
    AttnDesc d; d.cfg = uid >> 10; d.bl = (uid >> 9) & 1; d.head = (uid >> 6) & 7; const int j = uid & 63;
    d.lg = (d.cfg == 1) ? 2 : ((d.cfg == 2) ? 4 : 0); d.res = j & ((1 << d.lg) - 1); d.nb = j >> d.lg;
    if (d.cfg < 3) { d.qcol = d.head * 64; d.kcol = 512 + d.head * 64; d.vcol = 1024 + d.head * 64; } else { d.qcol = 1536 + d.head * 64; d.kcol = 2048 + (d.head >> 2) * 64; d.vcol = 2176 + (d.head >> 2) * 64; }
    return d;
}
__device__ __forceinline__ void attn_load(AttnRegs& R, const AttnDesc& d, GAS const bf16_t* UA, int tid, int lane, int w, int l15, int g) {
    const size_t rowbase = (size_t)d.bl * SEQ; const int lg = d.lg;
#pragma unroll
    for (int it = 0; it < 4; ++it) { const int key = (tid >> 3) + 64 * it, ch = tid & 7; const int t = (d.nb - 1) * 128 + key; u32x4 v = (u32x4){0u, 0u, 0u, 0u};
        if (t >= 0) v = __builtin_nontemporal_load((GAS const u32x4*)(UA + (rowbase + ((size_t)t << lg) + d.res) * 2304 + d.kcol + ch * 8));
        R.k[it] = v; }
#pragma unroll
    for (int it = 0; it < 4; ++it) { const int key = (tid >> 3) + 64 * it, ch = tid & 7; const int t = (d.nb - 1) * 128 + key; u32x4 v = (u32x4){0u, 0u, 0u, 0u};
        if (t >= 0) v = __builtin_nontemporal_load((GAS const u32x4*)(UA + (rowbase + ((size_t)t << lg) + d.res) * 2304 + d.vcol + ch * 8));
        R.v[it] = v; }
    { const int tq = d.nb * 128 + 16 * w + l15; GAS const bf16_t* qp = UA + (rowbase + ((size_t)tq << lg) + d.res) * 2304 + d.qcol + 8 * g; R.q0 = __builtin_nontemporal_load((GAS const bf16x8*)qp); R.q1 = __builtin_nontemporal_load((GAS const bf16x8*)(qp + 32)); }
}
__device__ __forceinline__ void attn_stage(const AttnRegs& R, LAS unsigned char* lds, int tid, int lane, int w) {
    LAS bf16_t* Ks = (LAS bf16_t*)lds; LAS bf16_t* Vs = (LAS bf16_t*)(lds + 256 * 72 * 2);
#pragma unroll
    for (int it = 0; it < 4; ++it) { const int key = (tid >> 3) + 64 * it, ch = tid & 7; *(LAS u32x4*)(Ks + key * 72 + ch * 8) = R.k[it]; *(LAS u32x4*)(Vs + key * 72 + ch * 8) = R.v[it]; }
}
__device__ __forceinline__ void attn_compute(const AttnDesc& d, bf16x8 q0, bf16x8 q1, LAS unsigned char* lds, GAS bf16_t* YAP, GAS float* LSE, GAS bf16_t* YB, GAS const float* sinks, int w, int l15, int g) {
    const int cfg = d.cfg, lg = d.lg, res = d.res, nb = d.nb, head = d.head; const size_t rowbase = (size_t)d.bl * SEQ;
    const int maxd = (cfg == 3) ? 127 : 128;
    LAS bf16_t* Ks = (LAS bf16_t*)lds; LAS bf16_t* Vt = (LAS bf16_t*)(lds + 256 * 72 * 2);
    const int kt0 = w & ~1;
    f32x4 s[10];
#pragma unroll
    for (int hb = 0; hb < 2; ++hb) {
        bf16x8 ka[5][2];
#pragma unroll
        for (int t5 = 0; t5 < 5; ++t5) { const LAS bf16_t* kp = Ks + (16 * (kt0 + 5 * hb + t5) + l15) * 72 + 8 * g; ka[t5][0] = *(const LAS bf16x8*)kp; ka[t5][1] = *(const LAS bf16x8*)(kp + 32); }
        __builtin_amdgcn_sched_barrier(0);
#pragma unroll
        for (int t5 = 0; t5 < 5; ++t5) { s[5 * hb + t5] = mfma16(ka[t5][0], q0, (f32x4){0.f, 0.f, 0.f, 0.f}); s[5 * hb + t5] = mfma16(ka[t5][1], q1, s[5 * hb + t5]); }
        __builtin_amdgcn_sched_barrier(0); }
    const int ql = 16 * w + l15; float mx = -1e30f;
#pragma unroll
    for (int tt = 0; tt < 10; ++tt)
#pragma unroll
        for (int jj = 0; jj < 4; ++jj) { const int kj = 16 * (kt0 + tt) + 4 * g + jj; const int dist = 128 + ql - kj;
            const bool valid = (dist >= 0) && (dist <= maxd) && (nb > 0 || kj >= 128);
            const float v = valid ? s[tt][jj] : -1e30f; s[tt][jj] = v; mx = fmaxf(mx, v); }
    mx = fmaxf(mx, __shfl_xor(mx, 16)); mx = fmaxf(mx, __shfl_xor(mx, 32));
    float sk = -1e30f; if (cfg == 3) { sk = sinks[head] * LOG2E; mx = fmaxf(mx, sk); }
    float sum = 0.f;
#pragma unroll
    for (int tt = 0; tt < 10; ++tt)
#pragma unroll
        for (int jj = 0; jj < 4; ++jj) { const float p = __builtin_amdgcn_exp2f(s[tt][jj] - mx); s[tt][jj] = p; sum += p; }
    sum += __shfl_xor(sum, 16); sum += __shfl_xor(sum, 32);
    if (cfg == 3) sum += __builtin_amdgcn_exp2f(sk - mx);
    f32x4 o[4];
#pragma unroll
    for (int db = 0; db < 4; ++db) o[db] = (f32x4){0.f, 0.f, 0.f, 0.f};
#pragma unroll
    for (int pp = 0; pp < 5; ++pp) { u32x4 pw; pw.x = pkbf(s[2 * pp][0], s[2 * pp][1]); pw.y = pkbf(s[2 * pp][2], s[2 * pp][3]); pw.z = pkbf(s[2 * pp + 1][0], s[2 * pp + 1][1]); pw.w = pkbf(s[2 * pp + 1][2], s[2 * pp + 1][3]);
        const bf16x8 pf = __builtin_bit_cast(bf16x8, pw);
        v4i16_t lo[4], hi[4];
#pragma unroll
        for (int db = 0; db < 4; ++db) { const LAS bf16_t* vp = Vt + (16 * (kt0 + 2 * pp) + 4 * g + (l15 >> 2)) * 72 + 16 * db + 4 * (l15 & 3);
            lo[db] = __builtin_amdgcn_ds_read_tr16_b64_v4i16((LAS v4i16_t*)vp); hi[db] = __builtin_amdgcn_ds_read_tr16_b64_v4i16((LAS v4i16_t*)(vp + 16 * 72)); }
        __builtin_amdgcn_sched_barrier(0);
#pragma unroll
        for (int db = 0; db < 4; ++db) { const bf16x8 bw = (bf16x8){lo[db][0], lo[db][1], lo[db][2], lo[db][3], hi[db][0], hi[db][1], hi[db][2], hi[db][3]};
            o[db] = mfma16(bw, pf, o[db]); }
        __builtin_amdgcn_sched_barrier(0); }
    const float linv = 1.0f / sum;
    GAS bf16_t* obase = (cfg < 3) ? (YAP + (size_t)cfg * MH * 512) : YB;
    { const int tq = nb * 128 + 16 * w + l15; const size_t grow = rowbase + ((size_t)tq << lg) + res;
      GAS bf16_t* op = obase + grow * 512 + head * 64 + 4 * g;
#pragma unroll
      for (int db = 0; db < 4; ++db) { u32x2 pk; pk.x = pkbf(o[db][0] * linv, o[db][1] * linv); pk.y = pkbf(o[db][2] * linv, o[db][3] * linv); __builtin_nontemporal_store(pk, (GAS u32x2*)(op + 16 * db)); } }
    if (cfg < 3 && g == 0) { const int tq = nb * 128 + 16 * w + l15; const size_t grow = rowbase + ((size_t)tq << lg) + res; LSE[((size_t)cfg * MH + grow) * 8 + head] = mx + __builtin_amdgcn_logf(sum); }
}
#define LBAR() asm volatile("s_waitcnt lgkmcnt(0)\n\ts_barrier" ::: "memory")
__device__ __forceinline__ void attn_run(LAS unsigned char* lds, int u0, int stride, int nunits, GAS const bf16_t* UA, GAS bf16_t* YAP, GAS float* LSE, GAS bf16_t* YB, GAS const float* sinks) {
    int tid_l = threadIdx.x; asm volatile("" : "+v"(tid_l)); const int tid = tid_l, lane = tid & 63, w = __builtin_amdgcn_readfirstlane(tid >> 6), l15 = lane & 15, g = lane >> 4;
    if (u0 >= nunits) return;
    AttnRegs R; AttnDesc d = attn_desc(u0);
    attn_load(R, d, UA, tid, lane, w, l15, g);
    for (int u = u0; u < nunits; u += stride) {
        attn_stage(R, lds, tid, lane, w);
        const bf16x8 q0 = R.q0, q1 = R.q1; const AttnDesc dc = d;
        LBAR();
        if (u + stride < nunits) { d = attn_desc(u + stride); attn_load(R, d, UA, tid, lane, w, l15, g); }
        attn_compute(dc, q0, q1, lds, YAP, LSE, YB, sinks, w, l15, g);
        LBAR();
    }
}

__device__ __forceinline__ int frag16(int row, int k, int nkk) { return ((((row >> 4) * nkk + (k >> 5)) * 64 + ((k >> 3) & 3) * 16 + (row & 15)) << 3) + (k & 7); }
__device__ __forceinline__ void prep_unit(LAS unsigned char* lds, int item, GAS const bf16_t* UC, GAS const float* UAB, GAS const float* convw, GAS const float* a_log, GAS const float* dt_bias,
                                          GAS bf16_t* Wg, GAS bf16_t* QD, GAS bf16_t* KDT, GAS bf16_t* UT, GAS bf16_t* ATT, GAS float* GL) {
    int tid_l = threadIdx.x; asm volatile("" : "+v"(tid_l)); const int tid = tid_l, lane = tid & 63, w = __builtin_amdgcn_readfirstlane(tid >> 6), l15 = lane & 15, g = lane >> 4;
    const int n = item & 127, hv = (item >> 7) & 7, bl = item >> 10, hk = hv >> 1;
    const size_t row0 = (size_t)bl * SEQ + (size_t)n * 64;
    LAS bf16_t* Kb = (LAS bf16_t*)lds; LAS bf16_t* Qb = (LAS bf16_t*)(lds + 17408); LAS bf16_t* Vb = (LAS bf16_t*)(lds + 34816);
    LAS float* AT = (LAS float*)(lds + 52224); LAS bf16_t* Ab = (LAS bf16_t*)(lds + 69632); LAS bf16_t* XT = (LAS bf16_t*)(lds + 78848); LAS float* RB = (LAS float*)(lds + 115712);
    LAS float* gcs = (LAS float*)(lds + 132352); LAS float* betas = (LAS float*)(lds + 132608);
    GAS bf16_t* Wi = Wg + (size_t)item * 8192; GAS bf16_t* QDi = QD + (size_t)item * 8192; GAS bf16_t* KDTi = KDT + (size_t)item * 8192; GAS bf16_t* UTi = UT + (size_t)item * 8192; GAS bf16_t* ATTi = ATT + (size_t)item * 4096;
    if (w == 0) { const float ca = UAB[(row0 + lane) * 16 + hv], cb = UAB[(row0 + lane) * 16 + 8 + hv];
        const float xg = ca + dt_bias[hv]; const float sp = (xg > 20.f) ? xg : __logf(1.0f + __expf(xg)); float gg = -__expf(a_log[hv]) * sp;
#pragma unroll
        for (int off = 1; off < 64; off <<= 1) { const float t = __shfl_up(gg, off); if (lane >= off) gg += t; }
        gcs[lane] = gg; betas[lane] = sigmoidf_(cb); if (lane == 63) GL[item] = __expf(gg); }
    __syncthreads();
    { const int ch = tid & 15, r = tid >> 4;
      u32x4 xv[3][5]; f32x4 cw[3][4][2];
#pragma unroll
      for (int tz = 0; tz < 3; ++tz) { const int col = ((tz == 0) ? hk * 128 : (tz == 1) ? 512 + hk * 128 : 1024 + hv * 128) + 8 * ch;
#pragma unroll
        for (int jt = 0; jt < 5; ++jt) { const int sp = n * 64 + 2 * r - 3 + jt; const int spc = sp < 0 ? 0 : sp;
            u32x4 v = *(GAS const u32x4*)(UC + ((size_t)bl * SEQ + spc) * 2048 + col); if (sp < 0) v = (u32x4){0u, 0u, 0u, 0u}; xv[tz][jt] = v; }
#pragma unroll
        for (int jt = 0; jt < 4; ++jt) { cw[tz][jt][0] = *(GAS const f32x4*)(convw + jt * 2048 + col); cw[tz][jt][1] = *(GAS const f32x4*)(convw + jt * 2048 + col + 4); } }
#pragma unroll
      for (int tz = 0; tz < 3; ++tz) {
#pragma unroll
        for (int rh = 0; rh < 2; ++rh) { const int rr = 2 * r + rh;
            float y[8];
#pragma unroll
            for (int i = 0; i < 8; ++i) y[i] = 0.f;
#pragma unroll
            for (int jt = 0; jt < 4; ++jt) { const u32x4 x = xv[tz][rh + jt]; const f32x4 w0 = cw[tz][jt][0], w1 = cw[tz][jt][1];
                y[0] += bf_lo(x.x) * w0[0]; y[1] += bf_hi(x.x) * w0[1]; y[2] += bf_lo(x.y) * w0[2]; y[3] += bf_hi(x.y) * w0[3];
                y[4] += bf_lo(x.z) * w1[0]; y[5] += bf_hi(x.z) * w1[1]; y[6] += bf_lo(x.w) * w1[2]; y[7] += bf_hi(x.w) * w1[3]; }
#pragma unroll
            for (int i = 0; i < 8; ++i) y[i] = y[i] * sigmoidf_(y[i]);
            if (tz < 2) { float ssq = 0.f;
#pragma unroll
                for (int i = 0; i < 8; ++i) ssq += y[i] * y[i];
                ssq += __shfl_xor(ssq, 1); ssq += __shfl_xor(ssq, 2); ssq += __shfl_xor(ssq, 4); ssq += __shfl_xor(ssq, 8);
                float rn = rsqrtf(ssq + EPS); if (tz == 0) rn *= 0.08838834764831845f;
#pragma unroll
                for (int i = 0; i < 8; ++i) y[i] *= rn; }
            u32x4 pk; pk.x = pkbf(y[0], y[1]); pk.y = pkbf(y[2], y[3]); pk.z = pkbf(y[4], y[5]); pk.w = pkbf(y[6], y[7]);
            LAS bf16_t* dst = (tz == 0) ? Qb : (tz == 1) ? Kb : Vb;
            *(LAS u32x4*)(dst + rr * 136 + 8 * ch) = pk;
            if (tz == 0) { const float e = __expf(gcs[rr]); u32x4 qd; qd.x = pkbf(y[0] * e, y[1] * e); qd.y = pkbf(y[2] * e, y[3] * e); qd.z = pkbf(y[4] * e, y[5] * e); qd.w = pkbf(y[6] * e, y[7] * e);
                __builtin_nontemporal_store(qd, (GAS u32x4*)(QDi + frag16(rr, 8 * ch, 4))); } } } }
    __syncthreads();
    { const int rt = w & 3;
#pragma unroll
      for (int cc = 0; cc < 2; ++cc) { const int ct = 2 * (w >> 2) + cc;
        f32x4 d1 = (f32x4){0.f, 0.f, 0.f, 0.f}, d2 = (f32x4){0.f, 0.f, 0.f, 0.f};
        bf16x8 ka[4], kb2[4], qb2[4];
#pragma unroll
        for (int kk = 0; kk < 4; ++kk) { ka[kk] = *(const LAS bf16x8*)(Kb + (16 * rt + l15) * 136 + 32 * kk + 8 * g); kb2[kk] = *(const LAS bf16x8*)(Kb + (16 * ct + l15) * 136 + 32 * kk + 8 * g);
                                         qb2[kk] = *(const LAS bf16x8*)(Qb + (16 * ct + l15) * 136 + 32 * kk + 8 * g); }
        __builtin_amdgcn_sched_barrier(0);
#pragma unroll
        for (int kk = 0; kk < 4; ++kk) { d1 = mfma16(ka[kk], kb2[kk], d1); d2 = mfma16(ka[kk], qb2[kk], d2); }
        { const int jx = 16 * ct + l15; const float gj = gcs[jx]; f32x4 o;
#pragma unroll
          for (int jj = 0; jj < 4; ++jj) { const int c = 16 * rt + 4 * g + jj; o[jj] = (jx < c) ? d1[jj] * __expf(gcs[c] - gj) * betas[c] : 0.f; }
          *(LAS f32x4*)(AT + jx * 68 + 16 * rt + 4 * g) = o;
          const unsigned p01 = pkbf(o[0], o[1]), p23 = pkbf(o[2], o[3]);
          Ab[(16 * rt + 4 * g + 0) * 72 + jx] = (bf16_t)(p01 & 0xffffu); Ab[(16 * rt + 4 * g + 1) * 72 + jx] = (bf16_t)(p01 >> 16);
          Ab[(16 * rt + 4 * g + 2) * 72 + jx] = (bf16_t)(p23 & 0xffffu); Ab[(16 * rt + 4 * g + 3) * 72 + jx] = (bf16_t)(p23 >> 16); }
        { const int c = 16 * ct + l15; const float gc = gcs[c]; float o[4];
#pragma unroll
          for (int jj = 0; jj < 4; ++jj) { const int jx = 16 * rt + 4 * g + jj; o[jj] = (jx <= c) ? d2[jj] * __expf(gc - gcs[jx]) : 0.f; }
          u32x2 pk; pk.x = pkbf(o[0], o[1]); pk.y = pkbf(o[2], o[3]);
          __builtin_nontemporal_store(pk, (GAS u32x2*)(ATTi + frag16(c, 16 * rt + 4 * g, 2))); } } }
    __syncthreads();
    int vz; asm volatile("v_mov_b32 %0, 0" : "=v"(vz));
    const LAS float* ATz = AT + vz;
    LAS bf16_t* Tb = (LAS bf16_t*)(lds + 115712);
    LAS bf16_t* TM = (LAS bf16_t*)(lds + 115712 + 2048);
    if (tid < 64) { const int blk = tid >> 4, col = tid & 15; float r[16];
#pragma unroll
        for (int c = 0; c < 16; ++c) r[c] = (c == col) ? 1.f : 0.f;
#pragma unroll
        for (int jx = 0; jx < 15; ++jx) { const float xj = r[jx];
#pragma unroll
            for (int c = jx + 1; c < 16; ++c) r[c] -= ATz[(16 * blk + jx) * 68 + 16 * blk + c] * xj; }
#pragma unroll
        for (int c = 0; c < 16; ++c) Tb[(16 * blk + c) * 16 + col] = (bf16_t)(pkbf(r[c], 0.f) & 0xffffu);
    } else if (tid >= 256) { const int t2 = tid - 256, dk = t2 & 127, hf = t2 >> 7; const LAS float* gz = gcs + vz; const float gl = gz[63];
#pragma unroll
        for (int q = 0; q < 4; ++q) { float v[8];
#pragma unroll
            for (int e = 0; e < 8; ++e) { const int c = 32 * hf + 8 * q + e; v[e] = bf_lo((unsigned)Kb[c * 136 + dk]) * __expf(gl - gz[c]); }
            u32x4 pk; pk.x = pkbf(v[0], v[1]); pk.y = pkbf(v[2], v[3]); pk.z = pkbf(v[4], v[5]); pk.w = pkbf(v[6], v[7]);
            __builtin_nontemporal_store(pk, (GAS u32x4*)(KDTi + frag16(dk, 32 * hf + 8 * q, 2))); } }
    __syncthreads();
#pragma unroll
    for (int i = 0; i < 4; ++i) {
        u32x4 tf = (u32x4){0u, 0u, 0u, 0u}; if (g < 2) tf = *(const LAS u32x4*)(Tb + (16 * i + l15) * 16 + 8 * g);
        f32x4 acc[2]; float rh[2][4];
        u32x4 af[2], bfv[2][2];
#pragma unroll
        for (int kk = 0; kk < 2; ++kk) { af[kk] = (u32x4){0u, 0u, 0u, 0u};
#pragma unroll
            for (int tt = 0; tt < 2; ++tt) bfv[tt][kk] = (u32x4){0u, 0u, 0u, 0u};
            if (32 * kk < 16 * i) { const bool keep = (32 * kk + 8 * g) < 16 * i;
                u32x4 a_ = *(const LAS u32x4*)(Ab + (16 * i + l15) * 72 + 32 * kk + 8 * g); if (keep) af[kk] = a_;
#pragma unroll
                for (int tt = 0; tt < 2; ++tt) { u32x4 b_ = *(const LAS u32x4*)(XT + (16 * (2 * w + tt) + l15) * 72 + 32 * kk + 8 * g); if (keep) bfv[tt][kk] = b_; } } }
#pragma unroll
        for (int tt = 0; tt < 2; ++tt) { const int t = 2 * w + tt; const int nn = 16 * t + l15;
#pragma unroll
            for (int jj = 0; jj < 4; ++jj) { const int c = 16 * i + 4 * g + jj;
                if (t < 8) rh[tt][jj] = bf_lo((unsigned)Vb[c * 136 + nn]) * betas[c]; else rh[tt][jj] = bf_lo((unsigned)Kb[c * 136 + nn - 128]) * betas[c] * __expf(gcs[c]); } }
        __builtin_amdgcn_sched_barrier(0);
#pragma unroll
        for (int tt = 0; tt < 2; ++tt) { acc[tt] = (f32x4){0.f, 0.f, 0.f, 0.f};
#pragma unroll
            for (int kk = 0; kk < 2; ++kk) if (32 * kk < 16 * i) acc[tt] = mfma16(__builtin_bit_cast(bf16x8, af[kk]), __builtin_bit_cast(bf16x8, bfv[tt][kk]), acc[tt]); }
#pragma unroll
        for (int tt = 0; tt < 2; ++tt) { const int nn = 16 * (2 * w + tt) + l15; u32x2 pk; pk.x = pkbf(rh[tt][0] - acc[tt][0], rh[tt][1] - acc[tt][1]); pk.y = pkbf(rh[tt][2] - acc[tt][2], rh[tt][3] - acc[tt][3]);
            *(LAS u32x2*)(TM + nn * 24 + 4 * g) = pk; }
        asm volatile("s_waitcnt lgkmcnt(0)" ::: "memory");
        u32x4 bm[2];
#pragma unroll
        for (int tt = 0; tt < 2; ++tt) { const int nn = 16 * (2 * w + tt) + l15; bm[tt] = (u32x4){0u, 0u, 0u, 0u}; if (g < 2) bm[tt] = *(const LAS u32x4*)(TM + nn * 24 + 8 * g); }
#pragma unroll
        for (int tt = 0; tt < 2; ++tt) { const int t = 2 * w + tt; const int nn = 16 * t + l15;
            const f32x4 x = mfma16(__builtin_bit_cast(bf16x8, tf), __builtin_bit_cast(bf16x8, bm[tt]), (f32x4){0.f, 0.f, 0.f, 0.f});
            const unsigned x01 = pkbf(x[0], x[1]), x23 = pkbf(x[2], x[3]);
            *(LAS u32x2*)(XT + nn * 72 + 16 * i + 4 * g) = (u32x2){x01, x23};
            if (t < 8) { __builtin_nontemporal_store((u32x2){x01, x23}, (GAS u32x2*)(UTi + (((t * 4 + i) * 64 + g * 16 + l15) << 2)));
            } else { const int dk = nn - 128; GAS bf16_t* wp = Wi + frag16(16 * i + 4 * g, dk, 4);
                wp[0] = (bf16_t)(x01 & 0xffffu); wp[8] = (bf16_t)(x01 >> 16); wp[16] = (bf16_t)(x23 & 0xffffu); wp[24] = (bf16_t)(x23 >> 16); } }
        asm volatile("s_waitcnt lgkmcnt(0)" ::: "memory");
    }
    __syncthreads();
}

struct ScanFrags { bf16x8 m[4]; bf16x8 x[2]; bf16x8 kf[2]; u32x2 uf[2]; float gl; };
__device__ __forceinline__ void scan_load(ScanFrags& f, int item, int w, int lane, int dvb, GAS const bf16_t* Wg, GAS const bf16_t* QD, GAS const bf16_t* KDT, GAS const bf16_t* UT, GAS const bf16_t* ATT, GAS const float* GL) {
    const int rt = w & 3;
    GAS const bf16_t* mb = ((w < 4) ? Wg : QD) + (size_t)item * 8192 + (rt * 4) * 512 + lane * 8;
#pragma unroll
    for (int kk = 0; kk < 4; ++kk) f.m[kk] = *(GAS const bf16x8*)(mb + kk * 512);
    if (w < 4) {
#pragma unroll
        for (int ct = 0; ct < 2; ++ct) f.uf[ct] = *(GAS const u32x2*)(UT + (size_t)item * 8192 + (((dvb * 2 + ct) * 4 + rt) * 64 + lane) * 4);
    } else {
#pragma unroll
        for (int kk = 0; kk < 2; ++kk) f.x[kk] = *(GAS const bf16x8*)(ATT + (size_t)item * 4096 + ((rt * 2 + kk) * 64 + lane) * 8);
    }
#pragma unroll
    for (int kk = 0; kk < 2; ++kk) f.kf[kk] = *(GAS const bf16x8*)(KDT + (size_t)item * 8192 + ((w * 2 + kk) * 64 + lane) * 8);
    f.gl = GL[item];
}
__device__ __forceinline__ void scan_step(const ScanFrags& f, int n, int bl, int hv, int dvb, int w, int l15, int g, LAS bf16_t* STc, LAS bf16_t* STn, LAS bf16_t* VNT, f32x4 (&S)[2], GAS bf16_t* O) {
    const int rt = w & 3;
    f32x4 acc[2];
#pragma unroll
    for (int ct = 0; ct < 2; ++ct) { acc[ct] = (f32x4){0.f, 0.f, 0.f, 0.f};
#pragma unroll
        for (int kk = 0; kk < 4; ++kk) { const bf16x8 sb = *(const LAS bf16x8*)(STc + (16 * ct + l15) * 136 + 32 * kk + 8 * g); acc[ct] = mfma16(f.m[kk], sb, acc[ct]); } }
    if (w < 4) {
#pragma unroll
        for (int ct = 0; ct < 2; ++ct) { const float v0 = bf_lo(f.uf[ct].x) - acc[ct][0], v1 = bf_hi(f.uf[ct].x) - acc[ct][1], v2 = bf_lo(f.uf[ct].y) - acc[ct][2], v3 = bf_hi(f.uf[ct].y) - acc[ct][3];
            u32x2 pk; pk.x = pkbf(v0, v1); pk.y = pkbf(v2, v3); *(LAS u32x2*)(VNT + (16 * ct + l15) * 72 + 16 * rt + 4 * g) = pk; }
    }
    LBAR();
    if (w >= 4) {
#pragma unroll
        for (int ct = 0; ct < 2; ++ct) {
#pragma unroll
            for (int kk = 0; kk < 2; ++kk) { const bf16x8 vb = *(const LAS bf16x8*)(VNT + (16 * ct + l15) * 72 + 32 * kk + 8 * g); acc[ct] = mfma16(f.x[kk], vb, acc[ct]); }
            GAS bf16_t* op = O + ((size_t)bl * SEQ + (size_t)n * 64 + 16 * rt + 4 * g) * 1024 + hv * 128 + 32 * dvb + 16 * ct + l15;
            const unsigned o01 = pkbf(acc[ct][0], acc[ct][1]), o23 = pkbf(acc[ct][2], acc[ct][3]);
            op[0] = (bf16_t)(o01 & 0xffffu); op[1024] = (bf16_t)(o01 >> 16); op[2048] = (bf16_t)(o23 & 0xffffu); op[3072] = (bf16_t)(o23 >> 16); }
    }
#pragma unroll
    for (int c2 = 0; c2 < 2; ++c2) { f32x4 as = S[c2] * f.gl;
#pragma unroll
        for (int kk = 0; kk < 2; ++kk) { const bf16x8 vb = *(const LAS bf16x8*)(VNT + (16 * c2 + l15) * 72 + 32 * kk + 8 * g); as = mfma16(f.kf[kk], vb, as); }
        S[c2] = as; u32x2 pk; pk.x = pkbf(as[0], as[1]); pk.y = pkbf(as[2], as[3]);
        *(LAS u32x2*)(STn + (16 * c2 + l15) * 136 + 16 * w + 4 * g) = pk; }
    LBAR();
}
__device__ __forceinline__ void scan_unit(LAS unsigned char* lds, int unit, GAS const bf16_t* Wg, GAS const bf16_t* QD, GAS const bf16_t* KDT, GAS const bf16_t* UT, GAS const bf16_t* ATT, GAS const float* GL, GAS bf16_t* O) {
    int tid_l = threadIdx.x; asm volatile("" : "+v"(tid_l)); const int tid = tid_l, lane = tid & 63, w = __builtin_amdgcn_readfirstlane(tid >> 6), l15 = lane & 15, g = lane >> 4;
    const int dvb = unit & 3, hv = (unit >> 2) & 7, bl = unit >> 5; const int item0 = (bl * 8 + hv) * 128;
    LAS bf16_t* ST0 = (LAS bf16_t*)lds; LAS bf16_t* ST1 = (LAS bf16_t*)(lds + 8704); LAS bf16_t* VNT = (LAS bf16_t*)(lds + 17408);
    for (int i = tid; i < 8704 / 4; i += NTH) ((LAS unsigned*)lds)[i] = 0u;
    f32x4 S[2]; S[0] = (f32x4){0.f, 0.f, 0.f, 0.f}; S[1] = (f32x4){0.f, 0.f, 0.f, 0.f};
    __syncthreads();
    ScanFrags f0, f1, f2;
#define SLD(F, N) scan_load(F, item0 + (N), w, lane, dvb, Wg, QD, KDT, UT, ATT, GL)
#define SST(F, N) scan_step(F, (N), bl, hv, dvb, w, l15, g, ((N) & 1) ? ST1 : ST0, ((N) & 1) ? ST0 : ST1, VNT, S, O)
    SLD(f0, 0); SLD(f1, 1);
    for (int n = 0; n < 126; n += 3) {
        SLD(f2, n + 2); SST(f0, n);
        SLD(f0, n + 3); SST(f1, n + 1);
        SLD(f1, n + 4); SST(f2, n + 2);
    }
    SST(f0, 126); SST(f1, 127);
#undef SLD
#undef SST
}

#ifndef REP_G1
#define REP_G1 1
#endif
#ifndef REP_MIX1
#define REP_MIX1 1
#endif
#ifndef REP_MIX2
#define REP_MIX2 1
#endif
#ifndef REP_POST
#define REP_POST 1
#endif
#ifndef REP_BR
#define REP_BR 1
#endif
#ifndef REP_FF1
#define REP_FF1 1
#endif
#ifndef REP_CONV
#define REP_CONV 1
#endif
constexpr int LDS_CTL = 134144, LDS_BYTES = 135168;
__device__ __forceinline__ int next_item(GAS unsigned* ctr, LAS int* slot) {
    if (threadIdx.x == 0) *slot = (int)__hip_atomic_fetch_add(ctr, 1u, __ATOMIC_RELAXED, __HIP_MEMORY_SCOPE_AGENT);
    __syncthreads(); const int v = *slot; __syncthreads(); return v;
}
__device__ __forceinline__ float wave_sum(float v) {
#pragma unroll
    for (int o = 1; o < 64; o <<= 1) v += __shfl_xor(v, o);
    return v;
}


#define TIDS() int tid_l = threadIdx.x; asm volatile("" : "+v"(tid_l)); const int tid = tid_l, lane = tid & 63, wave = __builtin_amdgcn_readfirstlane(tid >> 6); \
    const int G = gridDim.x, bid = blockIdx.x; const int gw = bid * 8 + wave, ngw = G * 8; const int gt = bid * NTH + tid, ngt = G * NTH; (void)lane; (void)gw; (void)ngw; (void)gt; (void)ngt

__device__ __forceinline__ void phase_p0(const Args& a) {
    TIDS(); GAS unsigned char* ws = opq(a.ws);
    GAS float* ssb = (GAS float*)(ws + WS_SS); GAS float* cs = (GAS float*)(ws + WS_CS); GAS bf16_t* XB = (GAS bf16_t*)(ws + WS_XB);
    for (int m = gw; m < M; m += ngw) { GAS const f32x4* xr = (GAS const f32x4*)(GP(a.x) + (size_t)m * D_MODEL) + lane; float s = 0.f; GAS u32x2* o8 = (GAS u32x2*)(XB + (size_t)m * D_MODEL) + lane;
#pragma unroll
        for (int j = 0; j < 4; ++j) { const f32x4 v = xr[64 * j]; s += (v[0] * v[0] + v[1] * v[1]) + (v[2] * v[2] + v[3] * v[3]); u32x2 pk; pk.x = pkbf(v[0], v[1]); pk.y = pkbf(v[2], v[3]); o8[64 * j] = pk; }
        s = wave_sum(s); if (lane < 16) ssb[(size_t)m * 16 + lane] = (lane == 0) ? s : 0.f; }
    for (int e = gt; e < M * 8; e += ngt) { const int m = e >> 3, i = e & 7;
        const double fr = (i == 0) ? 1.0 : (i == 1) ? 0.19392274474868576 : (i == 2) ? 0.03760603093086393 : (i == 3) ? 0.007292664737217109 : (i == 4) ? 0.001414213562373095
                        : (i == 5) ? 0.0002742481756762073 : (i == 6) ? 5.318295896944988e-05 : 1.031338537721246e-05;
        const double t = (double)GP(a.pos)[m] * fr * 0.15915494309189535; const float tf = (float)(t - floor(t));
        cs[(size_t)m * 16 + i] = __builtin_amdgcn_cosf(tf); cs[(size_t)m * 16 + 8 + i] = __builtin_amdgcn_sinf(tf); }
}
__device__ __forceinline__ void phase_conv(const Args& a, int layer, LAS unsigned char* lds) { TIDS(); convert_weights(a, layer, lds, gw, ngw, wave, lane); }

__device__ __forceinline__ void phase_g1(const Args& a, int layer, int hf, LAS unsigned char* lds) {
    GAS unsigned char* ws = opq(a.ws); const size_t r0 = (size_t)hf * MH; const int G = gridDim.x, bid = blockIdx.x;
    pg8::Gemm gm{(const bf16_t*)(ws + WS_XB) + r0 * D_MODEL, (const bf16_t*)(ws + WS_WIN), MH, N_MAIN_PAD, D_MODEL}; pg8::StaticOrder S; S.init(MH, N_MAIN_PAD, G, bid);
    EpiG1 E{(GAS bf16_t*)(ws + WS_UA), (GAS bf16_t*)(ws + WS_UC), (GAS bf16_t*)(ws + WS_UZ), (GAS float*)(ws + WS_UAB), GP(a.b_in) + (size_t)layer * D_IN, (GAS const float*)(ws + WS_SS) + ((size_t)(2 * layer) * M + r0) * 16, (GAS const float*)(ws + WS_CS) + r0 * 16};
    pg8::gemm_phase<EpiG1, pg8::StaticOrder, true, true>(lds, gm, S, E);
}
__device__ __forceinline__ void phase_mix(const Args& a, int layer, int hf, int which, LAS unsigned char* lds, int rep = 0) {
    GAS unsigned char* ws = opq(a.ws); const int bid = blockIdx.x, G = gridDim.x; (void)hf; (void)rep;
    GAS const bf16_t* UA = (GAS const bf16_t*)(ws + WS_UA); GAS bf16_t* YAP = (GAS bf16_t*)(ws + WS_YAP); GAS float* LSE = (GAS float*)(ws + WS_LSE); GAS bf16_t* YB = (GAS bf16_t*)(ws + WS_YB);
    GAS bf16_t* Wg = (GAS bf16_t*)(ws + WS_W); GAS bf16_t* QD = (GAS bf16_t*)(ws + WS_QD); GAS bf16_t* KDT = (GAS bf16_t*)(ws + WS_KDT); GAS bf16_t* UT = (GAS bf16_t*)(ws + WS_UT); GAS bf16_t* ATT = (GAS bf16_t*)(ws + WS_ATT); GAS float* GL = (GAS float*)(ws + WS_GL);
    if (which == 0) {
        for (int it = bid; it < 2048; it += G)
            prep_unit(lds, it, (GAS const bf16_t*)(ws + WS_UC), (GAS const float*)(ws + WS_UAB), GP(a.conv_w) + (size_t)layer * 4 * 2048, GP(a.a_log) + layer * 8, GP(a.dt_bias) + layer * 8, Wg, QD, KDT, UT, ATT, GL);
    } else {
        if (bid < 64 && G > 64) { const int xq = bid >> 3; const int sq = (bid & 7) + 8 * (xq >> 2);
            scan_unit(lds, sq * 4 + (xq & 3), Wg, QD, KDT, UT, ATT, GL, (GAS bf16_t*)(ws + WS_O));
        } else attn_run(lds, bid - 64, G - 64, 4096, UA, YAP, LSE, YB, GP(a.sinks) + layer * 8);
    }
}
__device__ __forceinline__ void phase_post(const Args& a, int layer) {
    TIDS(); GAS unsigned char* ws = opq(a.ws);
    GAS const float* LSE = (GAS const float*)(ws + WS_LSE); GAS const bf16_t* YAP = (GAS const bf16_t*)(ws + WS_YAP); GAS bf16_t* YA = (GAS bf16_t*)(ws + WS_YA);
    for (int e = gt; e < MH * 64; e += ngt) { const int row = e >> 6, ch = e & 63, head = ch >> 3;
        const float l0 = LSE[((size_t)0 * MH + row) * 8 + head], l1 = LSE[((size_t)1 * MH + row) * 8 + head], l2 = LSE[((size_t)2 * MH + row) * 8 + head];
        const float mx = fmaxf(l0, fmaxf(l1, l2)); float w0 = __builtin_amdgcn_exp2f(l0 - mx), w1 = __builtin_amdgcn_exp2f(l1 - mx), w2 = __builtin_amdgcn_exp2f(l2 - mx);
        const float inv = 1.0f / (w0 + w1 + w2); w0 *= inv; w1 *= inv; w2 *= inv;
        const u32x4 p0 = __builtin_nontemporal_load((GAS const u32x4*)(YAP + ((size_t)0 * MH + row) * 512 + ch * 8)), p1 = __builtin_nontemporal_load((GAS const u32x4*)(YAP + ((size_t)1 * MH + row) * 512 + ch * 8)), p2 = __builtin_nontemporal_load((GAS const u32x4*)(YAP + ((size_t)2 * MH + row) * 512 + ch * 8));
        u32x4 o;
        o.x = pkbf(w0 * bf_lo(p0.x) + w1 * bf_lo(p1.x) + w2 * bf_lo(p2.x), w0 * bf_hi(p0.x) + w1 * bf_hi(p1.x) + w2 * bf_hi(p2.x));
        o.y = pkbf(w0 * bf_lo(p0.y) + w1 * bf_lo(p1.y) + w2 * bf_lo(p2.y), w0 * bf_hi(p0.y) + w1 * bf_hi(p1.y) + w2 * bf_hi(p2.y));
        o.z = pkbf(w0 * bf_lo(p0.z) + w1 * bf_lo(p1.z) + w2 * bf_lo(p2.z), w0 * bf_hi(p0.z) + w1 * bf_hi(p1.z) + w2 * bf_hi(p2.z));
        o.w = pkbf(w0 * bf_lo(p0.w) + w1 * bf_lo(p1.w) + w2 * bf_lo(p2.w), w0 * bf_hi(p0.w) + w1 * bf_hi(p1.w) + w2 * bf_hi(p2.w));
        __builtin_nontemporal_store(o, (GAS u32x4*)(YA + (size_t)row * 512 + ch * 8)); }
    GAS const float* cn = GP(a.c_norm) + layer * 128; GAS const bf16_t* Ob = (GAS const bf16_t*)(ws + WS_O); GAS const bf16_t* UZ = (GAS const bf16_t*)(ws + WS_UZ); GAS bf16_t* YC = (GAS bf16_t*)(ws + WS_YC);
    for (int e = gt; e < MH * 128; e += ngt) { const int row = e >> 7, ch = e & 127, d0 = (ch & 15) * 8;
        const u32x4 ov = __builtin_nontemporal_load((GAS const u32x4*)(Ob + (size_t)row * 1024 + ch * 8)); const f32x4 o0 = (f32x4){bf_lo(ov.x), bf_hi(ov.x), bf_lo(ov.y), bf_hi(ov.y)}, o1 = (f32x4){bf_lo(ov.z), bf_hi(ov.z), bf_lo(ov.w), bf_hi(ov.w)};
        float sq = (o0[0] * o0[0] + o0[1] * o0[1]) + (o0[2] * o0[2] + o0[3] * o0[3]) + (o1[0] * o1[0] + o1[1] * o1[1]) + (o1[2] * o1[2] + o1[3] * o1[3]);
        sq += __shfl_xor(sq, 1); sq += __shfl_xor(sq, 2); sq += __shfl_xor(sq, 4); sq += __shfl_xor(sq, 8);
        const float rs = rsqrtf(sq * (1.0f / 128.0f) + EPS);
        const u32x4 z = __builtin_nontemporal_load((GAS const u32x4*)(UZ + (size_t)row * 1024 + ch * 8)); const f32x4 g0 = *(GAS const f32x4*)(cn + d0), g1 = *(GAS const f32x4*)(cn + d0 + 4);
        const float z0 = bf_lo(z.x), z1 = bf_hi(z.x), z2 = bf_lo(z.y), z3 = bf_hi(z.y), z4 = bf_lo(z.z), z5 = bf_hi(z.z), z6 = bf_lo(z.w), z7 = bf_hi(z.w);
        u32x4 pk;
        pk.x = pkbf(o0[0] * rs * g0[0] * (z0 * sigmoidf_(z0)), o0[1] * rs * g0[1] * (z1 * sigmoidf_(z1)));
        pk.y = pkbf(o0[2] * rs * g0[2] * (z2 * sigmoidf_(z2)), o0[3] * rs * g0[3] * (z3 * sigmoidf_(z3)));
        pk.z = pkbf(o1[0] * rs * g1[0] * (z4 * sigmoidf_(z4)), o1[1] * rs * g1[1] * (z5 * sigmoidf_(z5)));
        pk.w = pkbf(o1[2] * rs * g1[2] * (z6 * sigmoidf_(z6)), o1[3] * rs * g1[3] * (z7 * sigmoidf_(z7)));
        __builtin_nontemporal_store(pk, (GAS u32x4*)(YC + (size_t)row * 1024 + ch * 8)); }
}
__device__ __forceinline__ void phase_gates(const Args& a, int layer, int hf, LAS unsigned char* lds) {
    GAS unsigned char* ws = opq(a.ws); const size_t r0 = (size_t)hf * MH; const int G = gridDim.x, bid = blockIdx.x;
    pg8::StaticOrder S; S.init(MH, 3072, G, bid);
    pg8::Gemm gm{(const bf16_t*)(ws + WS_XB) + r0 * D_MODEL, (const bf16_t*)(ws + WS_WG), MH, 3072, D_MODEL};
    EpiGate E{(GAS bf16_t*)(ws + WS_GA), GP(a.b_in) + (size_t)layer * D_IN + N_MAIN, (GAS const float*)(ws + WS_SS) + ((size_t)(2 * layer) * M + r0) * 16};
    pg8::gemm_phase<EpiGate, pg8::StaticOrder, true, true>(lds, gm, S, E);
}
template <int WHICH> __device__ __forceinline__ void phase_br_one(const Args& a, int layer, int hf, LAS unsigned char* lds) {
    GAS unsigned char* ws = opq(a.ws); const int G = gridDim.x, bid = blockIdx.x;
    pg8::StaticOrder S; S.init(MH, D_MODEL, G, bid);
    GAS f32x4* mscr = (GAS f32x4*)(ws + WS_MSCR) + (size_t)bid * 32 * NTH; GAS bf16_t* MRG = (GAS bf16_t*)(ws + WS_MRG);
    const bf16_t* A = (const bf16_t*)(ws + (WHICH == 0 ? WS_YA : WHICH == 1 ? WS_YB : WS_YC)); const bf16_t* B = (const bf16_t*)(ws + (WHICH == 0 ? WS_WA : WHICH == 1 ? WS_WB : WS_WC));
    pg8::Gemm gm{A, B, MH, D_MODEL, WHICH == 2 ? 1024 : 512}; EpiBranch<WHICH> E{(GAS const bf16_t*)(ws + (WHICH == 0 ? WS_GA : WHICH == 1 ? WS_GB : WS_GC)), mscr, MRG}; pg8::gemm_phase<EpiBranch<WHICH>, pg8::StaticOrder, true, true>(lds, gm, S, E);
}
__device__ __forceinline__ void phase_wo(const Args& a, int layer, int hf, LAS unsigned char* lds) {
    GAS unsigned char* ws = opq(a.ws); const size_t r0 = (size_t)hf * MH; const int G = gridDim.x, bid = blockIdx.x;
    pg8::Gemm gm{(const bf16_t*)(ws + WS_MRG), (const bf16_t*)(ws + WS_WO), MH, D_MODEL, D_MODEL}; pg8::StaticOrder S; S.init(MH, D_MODEL, G, bid);
    GAS const float* base = (layer == 0) ? (GP(a.x) + r0 * D_MODEL) : (GP(a.out) + r0 * D_MODEL);
    EpiResid E{base, GP(a.out) + r0 * D_MODEL, (GAS bf16_t*)(ws + WS_XB) + r0 * D_MODEL, (GAS float*)(ws + WS_SS) + ((size_t)(2 * layer + 1) * M + r0) * 16};
    pg8::gemm_phase<EpiResid, pg8::StaticOrder, true, true>(lds, gm, S, E);
}
__device__ __forceinline__ void phase_ff1(const Args& a, int layer, LAS unsigned char* lds) {
    GAS unsigned char* ws = opq(a.ws); const int G = gridDim.x, bid = blockIdx.x;
    pg8::Gemm gm{(const bf16_t*)(ws + WS_XB), (const bf16_t*)(ws + WS_W1), M, D_FF, D_MODEL}; pg8::StaticOrder S; S.init(M, D_FF, G, bid);
#ifdef T_SKIP_BRWO
    EpiRelu2 E{(GAS bf16_t*)(ws + WS_H1), (GAS const float*)(ws + WS_SS) + (size_t)(2 * layer) * M * 16};
#else
    EpiRelu2 E{(GAS bf16_t*)(ws + WS_H1), (GAS const float*)(ws + WS_SS) + (size_t)(2 * layer + 1) * M * 16};
#endif
    pg8::gemm_phase<EpiRelu2, pg8::StaticOrder, true, true>(lds, gm, S, E);
}
__device__ __forceinline__ void phase_ff2(const Args& a, int layer, LAS unsigned char* lds) {
    GAS unsigned char* ws = opq(a.ws); const int G = gridDim.x, bid = blockIdx.x;
    pg8::Gemm gm{(const bf16_t*)(ws + WS_H1), (const bf16_t*)(ws + WS_W2), M, D_MODEL, D_FF}; pg8::StaticOrder S; S.init(M, D_MODEL, G, bid);
#ifdef T_SKIP_BRWO
    EpiResid E{(layer == 0) ? GP(a.x) : GP(a.out), GP(a.out), (GAS bf16_t*)(ws + WS_XB), (GAS float*)(ws + WS_SS) + (size_t)(2 * layer + 2) * M * 16};
#else
    EpiResid E{GP(a.out), GP(a.out), (GAS bf16_t*)(ws + WS_XB), (GAS float*)(ws + WS_SS) + (size_t)(2 * layer + 2) * M * 16};
#endif
 pg8::gemm_phase<EpiResid, pg8::StaticOrder, true, true>(lds, gm, S, E);
}
__device__ __forceinline__ void phase_final(const Args& a) {
    TIDS(); GAS unsigned char* ws = opq(a.ws); GAS const float* ssf = (GAS const float*)(ws + WS_SS) + (size_t)4 * M * 16;
    for (int e = gt; e < M * 256; e += ngt) { const int m = e >> 8, c4 = e & 255; const float rs = row_rstd(ssf, m);
        GAS f32x4* p = (GAS f32x4*)(GP(a.out) + (size_t)m * D_MODEL) + c4; const f32x4 gn = *((GAS const f32x4*)GP(a.norm_final) + c4); *p = (*p) * rs * gn; }
}


#define XB_TMO      128
#define XB_XCNT(j)  (256  + 64 * (j))
#define XB_XSUB(j)  (1280 + 64 * (j))
#define XB_XGEN(j)  (2304 + 64 * (j))
#define XB_TOP      3328
#define XB_TOPGEN   3392
#define XCD_BAR_WORDS 3456
#define XB_SPIN_CAP (1u << 22)
__device__ __forceinline__ unsigned xb_ld(GAS unsigned* p)              { return __hip_atomic_load(p, __ATOMIC_RELAXED, __HIP_MEMORY_SCOPE_AGENT); }
__device__ __forceinline__ unsigned xb_add(GAS unsigned* p, unsigned v) { return __hip_atomic_fetch_add(p, v, __ATOMIC_RELAXED, __HIP_MEMORY_SCOPE_AGENT); }
__device__ __forceinline__ unsigned xb_xcc_id() { return (unsigned)__builtin_amdgcn_s_getreg((3 << 11) | 20) & 0xFu; }
#define XB_SPIN(cond, bar) do { unsigned _sp = 0; while (cond) { __builtin_amdgcn_s_sleep(1); \
    if ((++_sp & 255u) == 0u) { if (xb_ld(&(bar)[XB_TMO])) break; if (_sp > XB_SPIN_CAP) { xb_add(&(bar)[XB_TMO], 1u); break; } } } } while (0)
struct XcdBarrier { GAS unsigned* bar; unsigned x; volatile LAS unsigned* st; };
__device__ __forceinline__ XcdBarrier xcd_barrier_post(GAS unsigned* bar, volatile LAS unsigned* st) {
    XcdBarrier b; b.bar = bar; b.x = xb_xcc_id(); b.st = st;
    if (threadIdx.x == 0) (void)xb_add(&bar[XB_XCNT(b.x)], 1u);
    return b;
}
__device__ __forceinline__ void xcd_barrier_complete(GAS unsigned* bar, unsigned x, unsigned& nloc, unsigned& nx) {
    const unsigned G = gridDim.x * gridDim.y * gridDim.z;
    unsigned sum, cnt, mine, sp = 0u;
    for (;;) {
        sum = 0u; cnt = 0u; mine = 0u;
#pragma unroll
        for (unsigned j = 0; j < 16; ++j) { const unsigned c = xb_ld(&bar[XB_XCNT(j)]); sum += c; cnt += (c > 0u) ? 1u : 0u; mine = (j == x) ? c : mine; }
        if (sum == G) break;
        __builtin_amdgcn_s_sleep(1);
        if ((++sp & 255u) == 0u) { if (xb_ld(&bar[XB_TMO])) break; if (sp > XB_SPIN_CAP) { xb_add(&bar[XB_TMO], 1u); break; } }
    }
    nloc = mine > 0u ? mine : 1u; nx = cnt > 0u ? cnt : 1u;
}
__device__ __forceinline__ void xcd_barrier(const XcdBarrier& b) {
    asm volatile("s_waitcnt vmcnt(0)" ::: "memory");
    __syncthreads();
    if (threadIdx.x == 0) {
        GAS unsigned* bar = b.bar;
        __builtin_amdgcn_s_waitcnt(0);
        unsigned nloc = b.st[0], nx = b.st[1];
        if (nloc == 0u) { xcd_barrier_complete(bar, b.x, nloc, nx); b.st[0] = nloc; b.st[1] = nx; }
        const unsigned old = xb_add(&bar[XB_XSUB(b.x)], 1u);
        const unsigned gen = old / nloc;
        if (old + 1u == (gen + 1u) * nloc) {
            __builtin_amdgcn_fence(__ATOMIC_RELEASE, "agent");
            asm volatile("s_waitcnt vmcnt(0)" ::: "memory");
            const unsigned og = xb_add(&bar[XB_TOP], 1u);
            const unsigned tg = og / nx;
            if (og + 1u == (tg + 1u) * nx) xb_add(&bar[XB_TOPGEN], 1u);
            else XB_SPIN(xb_ld(&bar[XB_TOPGEN]) == tg, bar);
            __builtin_amdgcn_fence(__ATOMIC_ACQUIRE, "agent");
            xb_add(&bar[XB_XGEN(b.x)], 1u);
            asm volatile("s_waitcnt vmcnt(0)" ::: "memory");
        } else {
            XB_SPIN(xb_ld(&bar[XB_XGEN(b.x)]) == gen, bar);
            __builtin_amdgcn_fence(__ATOMIC_ACQUIRE, "agent");
            asm volatile("s_waitcnt vmcnt(0)" ::: "memory");
        }
    }
    __syncthreads();
}
__device__ __forceinline__ void gsync(cg::grid_group& grid) {
    asm volatile("s_waitcnt vmcnt(0) lgkmcnt(0)" ::: "memory");
    grid.sync();
    __builtin_amdgcn_fence(__ATOMIC_ACQUIRE, "agent");
    asm volatile("s_waitcnt vmcnt(0)" ::: "memory");
}
__global__ void __launch_bounds__(NTH, 2) mega_fwd(Args a) {
    extern __shared__ __attribute__((aligned(16))) unsigned char lds_raw[];
    LAS unsigned char* lds = (LAS unsigned char*)lds_raw;
    cg::grid_group grid = cg::this_grid();
    { volatile LAS unsigned* st = (volatile LAS unsigned*)(lds + LDS_CTL + 64); if (threadIdx.x < 2) st[threadIdx.x] = 0u; __syncthreads(); }
    const XcdBarrier xbar = xcd_barrier_post((GAS unsigned*)(opq(a.ws) + WS_CTL) + 4096, (volatile LAS unsigned*)(lds + LDS_CTL + 64));
#define XSYNC() xcd_barrier(xbar)
    phase_p0(a);
    for (int layer = 0; layer < DEPTH; ++layer) {
        for (int rep = 0; rep < REP_CONV; ++rep) phase_conv(a, layer, lds);
        gsync(grid);
        for (int hf = 0; hf < NSPLIT; ++hf) {
            for (int rep = 0; rep < REP_G1; ++rep) { phase_g1(a, layer, hf, lds); XSYNC(); }
            for (int rep = 0; rep < REP_MIX1; ++rep) { phase_mix(a, layer, hf, 0, lds, rep); XSYNC(); }
            for (int rep = 0; rep < REP_MIX2; ++rep) { phase_mix(a, layer, hf, 1, lds, rep); XSYNC(); }
            for (int rep = 0; rep < REP_POST; ++rep) { phase_post(a, layer); phase_gates(a, layer, hf, lds); XSYNC(); }
            for (int rep = 0; rep < REP_BR; ++rep) { phase_br_one<0>(a, layer, hf, lds); phase_br_one<1>(a, layer, hf, lds); phase_br_one<2>(a, layer, hf, lds); XSYNC(); }
            phase_wo(a, layer, hf, lds);
            XSYNC();
        }
        for (int rep = 1; rep < REP_FF1; ++rep) { phase_ff1(a, layer, lds); XSYNC(); }
        phase_ff1(a, layer, lds);
        XSYNC();
        phase_ff2(a, layer, lds);
        XSYNC();
    }
    phase_final(a);
}

extern "C" void kernel_launch(void* const* d_in, const int* in_sizes, int n_in, void* d_out, int out_size, void* d_ws, size_t ws_size, hipStream_t stream) {
    static int grid = 0;
    if (grid == 0) {
        if (n_in != 18 || out_size != M * D_MODEL || ws_size < WS_END) { fprintf(stderr, "kernel_launch: unexpected shapes: n_in %d out %d ws %zu\n", n_in, out_size, ws_size); grid = -1; return; }
        int dev = 0, cus = 0, per_cu = 0;
        hipGetDevice(&dev); hipDeviceGetAttribute(&cus, hipDeviceAttributeMultiprocessorCount, dev);
        if (hipFuncSetAttribute((const void*)mega_fwd, hipFuncAttributeMaxDynamicSharedMemorySize, LDS_BYTES) != hipSuccess) { fprintf(stderr, "kernel_launch: hipFuncSetAttribute failed\n"); grid = -1; return; }
        hipOccupancyMaxActiveBlocksPerMultiprocessor(&per_cu, (const void*)mega_fwd, NTH, LDS_BYTES);
        (void)hipGetLastError();
        if (per_cu < 1) per_cu = 1;
        grid = cus;
        fprintf(stderr, "kernel_launch: cus %d per_cu %d grid %d ws %zu\n", cus, per_cu, grid, ws_size);
    }
    if (grid < 0) return;
    hipMemsetAsync((char*)d_ws + WS_CTL, 0, CTL_BYTES, stream);
    Args a{};
    a.x = (const float*)d_in[0]; a.pos = (const int*)d_in[1]; a.norm_mix = (const float*)d_in[2]; a.w_in = (const float*)d_in[3]; a.b_in = (const float*)d_in[4];
    a.conv_w = (const float*)d_in[5]; a.a_log = (const float*)d_in[6]; a.dt_bias = (const float*)d_in[7]; a.sinks = (const float*)d_in[8]; a.c_norm = (const float*)d_in[9];
    a.wba = (const float*)d_in[10]; a.wbb = (const float*)d_in[11]; a.wbc = (const float*)d_in[12]; a.w_out = (const float*)d_in[13]; a.norm_ffn = (const float*)d_in[14];
    a.w_ff1 = (const float*)d_in[15]; a.w_ff2 = (const float*)d_in[16]; a.norm_final = (const float*)d_in[17]; a.out = (float*)d_out; a.ws = (unsigned char*)d_ws;
    void* args[] = {&a};
    hipError_t e = hipLaunchCooperativeKernel((const void*)mega_fwd, dim3(grid), dim3(NTH), args, LDS_BYTES, stream);
    if (e != hipSuccess) fprintf(stderr, "cooperative launch failed: %s (grid %d)\n", hipGetErrorString(e), grid);
}
```

```cpp
#include <hip/hip_runtime.h>
#include <cstdio>
#include <cstdint>
namespace pg8 {
#define PG8_LAS __attribute__((address_space(3)))
typedef unsigned short bf16_t;
typedef short bf16x8 __attribute__((ext_vector_type(8)));
typedef float f32x4 __attribute__((ext_vector_type(4)));
typedef unsigned u32x4 __attribute__((ext_vector_type(4)));
constexpr int BM = 256, BK = 64, HALF = 128, HTB = HALF * BK * 2  , STAGE_BYTES = 8 * HTB, NXCD = 8, WGM = 8;

__host__ __device__ __forceinline__ int lds_byte(int r, int c) { const int st = (r >> 4) * 2 + (c >> 5), rr = r & 15, cc = c & 31, ob = rr * 64 + cc * 2; return st * 1024 + (ob ^ (((ob >> 9) & 1) << 5)); }
__host__ __device__ __forceinline__ void stage_rc(int b, int& R, int& C) { const int st = b / 1024, sb = b % 1024, swz = sb ^ (((sb >> 9) & 1) << 5); R = (st >> 1) * 16 + swz / 64; C = (st & 1) * 32 + (swz % 64) / 2; }
__host__ __device__ __forceinline__ int perm32(int rho) { const int n = rho >> 4, i = rho & 15; return 8 * (i >> 2) + 4 * n + (i & 3); }

struct Unit { int pm, pn; };
struct Gemm { const bf16_t* A; const bf16_t* Bt; int M, N, K; };

struct StaticOrder {
    int nM, nN, nwg, G, c;
    __host__ __device__ void init(int M, int N, int G_, int c_) { nM = M / BM; nN = N / BM; nwg = nM * nN; G = G_; c = c_; }
    __host__ __device__ bool next(int i, Unit& u) const {
        const long L = (long)i * G + c; if (L >= nwg) return false;
        int wgid = (int)L; { const int q = nwg / NXCD, r = nwg % NXCD, xcd = wgid % NXCD, off = wgid / NXCD; wgid = (xcd < r ? xcd * (q + 1) : r * (q + 1) + (xcd - r) * q) + off; }
        const int nig = WGM * nN, gid = wgid / nig, fm = gid * WGM, gsz = (nM - fm) < WGM ? (nM - fm) : WGM;
        u.pm = fm + ((wgid % nig) % gsz); u.pn = (wgid % nig) / gsz; return true;
    }
    __device__ __forceinline__ void a_ready(const Unit&) const {}
    __device__ __forceinline__ void done(const Unit&) const {}
};

__device__ __forceinline__ unsigned cvt_pk_bf16(float lo, float hi) { unsigned r; asm volatile("v_cvt_pk_bf16_f32 %0, %1, %2" : "=v"(r) : "v"(lo), "v"(hi)); return r; }
typedef float f32x2 __attribute__((ext_vector_type(2)));
__device__ __forceinline__ f32x2 gelu_pk(f32x2 v) {
    const f32x2 av = __builtin_elementwise_abs(v), d = av * 0.2316418882f + 1.0f;
    f32x2 t; t.x = __builtin_amdgcn_rcpf(d.x); t.y = __builtin_amdgcn_rcpf(d.y);
    f32x2 q = t * 0.5307027145f + (-0.7265760135f); q = q * t + 0.7107068705f; q = q * t + (-0.142248368f); q = q * t + 0.127414796f; q = q * t;
    const f32x2 s = (v * v) * (-0.72134752044f);
    f32x2 e; e.x = __builtin_amdgcn_exp2f(s.x); e.y = __builtin_amdgcn_exp2f(s.y);
    const f32x2 m = v * (q * e), r = v - m;
    f32x2 o; o.x = v.x < 0.f ? m.x : r.x; o.y = v.y < 0.f ? m.y : r.y; return o;
}

template <int ACT  > struct EpiBf16 {
    static constexpr bool PERM = true, AFTER_DRAIN = false; static_assert(ACT == 0 || ACT == 1, "EpiBf16: ACT is 0 (none) or 1 (gelu_pk)");
    bf16_t* O; int ldc; const float* bias; int split_cols; size_t split_stride; float scale0;
    __device__ __forceinline__ void operator()(const f32x4 (&acc)[2][2][4][2], const Unit& u, int wr, int wc, int fr, int fq) const {
        const int row0 = u.pm * BM + wr * 64 + fr; int colt = u.pn * BM; bf16_t* base = O;
        float sc = 1.f; if (split_cols) { const int t = colt / split_cols; base += (size_t)t * split_stride; colt -= t * split_cols; if (t == 0) sc = scale0; }
        const int col0 = colt + wc * 32 + 8 * fq, bcol0 = u.pn * BM + wc * 32 + 8 * fq;
        f32x4 bv[2][2];
#pragma unroll
        for (int bj = 0; bj < 2; ++bj)
#pragma unroll
            for (int n = 0; n < 2; ++n) bv[bj][n] = bias ? *(const f32x4*)(bias + bcol0 + bj * HALF + 4 * n) : (f32x4){0.f, 0.f, 0.f, 0.f};
#pragma unroll
        for (int ai = 0; ai < 2; ++ai)
#pragma unroll
            for (int m = 0; m < 4; ++m) { bf16_t* rowp = base + (size_t)(row0 + ai * HALF + m * 16) * ldc + col0;
#pragma unroll
                for (int bj = 0; bj < 2; ++bj) { f32x4 v0 = acc[ai][bj][m][0] + bv[bj][0], v1 = acc[ai][bj][m][1] + bv[bj][1];
                    if (ACT == 1) { f32x2 a = gelu_pk((f32x2){v0[0], v0[1]}), b = gelu_pk((f32x2){v0[2], v0[3]}), c = gelu_pk((f32x2){v1[0], v1[1]}), d = gelu_pk((f32x2){v1[2], v1[3]});
                        v0 = (f32x4){a.x, a.y, b.x, b.y}; v1 = (f32x4){c.x, c.y, d.x, d.y}; }
                    v0 = v0 * sc; v1 = v1 * sc; u32x4 w; w.x = cvt_pk_bf16(v0[0], v0[1]); w.y = cvt_pk_bf16(v0[2], v0[3]); w.z = cvt_pk_bf16(v1[0], v1[1]); w.w = cvt_pk_bf16(v1[2], v1[3]);
                    *(u32x4*)(rowp + bj * HALF) = w; } }
    }
};
template <class Epi, class Sched, bool ALIGN_EPI = false, bool SP2 = false>
__device__ __forceinline__ void gemm_phase(PG8_LAS unsigned char* lds, const Gemm g, const Sched& S, const Epi& E) {
    int tid_l = threadIdx.x; asm volatile("" : "+v"(tid_l));
    const int tid = tid_l, wid = __builtin_amdgcn_readfirstlane(tid >> 6), lane = tid & 63, wr = wid >> 2, wc = wid & 3, fr = lane & 15, fq = lane >> 4;
    const int K = g.K, nt = K / BK;
    unsigned voffA[2], voffB[2];
#pragma unroll
    for (int i = 0; i < 2; ++i) { int R, C; stage_rc(tid * 16 + i * 8192, R, C); const int Rb = Epi::PERM ? ((R & ~31) + perm32(R & 31)) : R;
        voffA[i] = (unsigned)(R * K + C) * 2u; voffB[i] = (unsigned)(Rb * K + C) * 2u; }
    const size_t kstep = (size_t)(BK * 2);
    const size_t hstep = (size_t)HALF * K * 2;
    const size_t tstep = 2 * hstep;
    const unsigned ldsw = (unsigned)wid * 1024u;
    const int aoff = lds_byte(wr * 64 + fr, fq * 8), boff = lds_byte(wc * 32 + fr, fq * 8);
#define PG8_SA(b, h) (((b) * 2 + (h)) * HTB)
#define PG8_SB(b, h) ((4 + (b) * 2 + (h)) * HTB)
#define PG8_STAGE(bufoff, gbase, voff) do { _Pragma("unroll") for (int _i = 0; _i < 2; ++_i) \
        __builtin_amdgcn_global_load_lds((const unsigned*)((const char*)(gbase) + (voff)[_i]), (PG8_LAS unsigned*)(lds + (bufoff) + ldsw + _i * 8192), 16, 0, 0); } while (0)
#define PG8_LDA(dst, b, h) do { _Pragma("unroll") for (int m = 0; m < 4; ++m) _Pragma("unroll") for (int k = 0; k < 2; ++k) dst[m][k] = *(const PG8_LAS bf16x8*)(lds + PG8_SA(b, h) + aoff + m * 2048 + k * 1024); } while (0)
#define PG8_LDB(dst, b, h) do { _Pragma("unroll") for (int n = 0; n < 2; ++n) _Pragma("unroll") for (int k = 0; k < 2; ++k) dst[n][k] = *(const PG8_LAS bf16x8*)(lds + PG8_SB(b, h) + boff + n * 2048 + k * 1024); } while (0)
#define PG8_MMA(ai, bj, At, Bt) do { __builtin_amdgcn_s_setprio(1); _Pragma("unroll") for (int m = 0; m < 4; ++m) _Pragma("unroll") for (int n = 0; n < 2; ++n) _Pragma("unroll") for (int k = 0; k < 2; ++k) \
        acc[ai][bj][m][n] = __builtin_amdgcn_mfma_f32_16x16x32_bf16(Bt[n][k], At[m][k], acc[ai][bj][m][n], 0, 0, 0); __builtin_amdgcn_s_setprio(0); } while (0)
#define PG8_WAIT_V(n) asm volatile("s_waitcnt vmcnt(" #n ")" ::: "memory")
#define PG8_WAIT_L(n) asm volatile("s_waitcnt lgkmcnt(" #n ")" ::: "memory")
#define PG8_BAR __builtin_amdgcn_s_barrier()
#define PG8_SCHED __builtin_amdgcn_sched_barrier(0)
    Unit cur, nxt; int ui = 0;
    if (!S.next(0, cur)) return;
    f32x4 acc[2][2][4][2];
#pragma unroll
    for (int a = 0; a < 2; ++a)
#pragma unroll
        for (int b = 0; b < 2; ++b)
#pragma unroll
            for (int m = 0; m < 4; ++m)
#pragma unroll
                for (int n = 0; n < 2; ++n) acc[a][b][m][n] = (f32x4){0.f, 0.f, 0.f, 0.f};
    bf16x8 At[4][2], B0[2][2], B1[2][2];
    const char* cA = (const char*)g.A + (size_t)cur.pm * tstep; const char* cB = (const char*)g.Bt + (size_t)cur.pn * tstep;
    S.a_ready(cur);
    if constexpr (SP2) {
        PG8_STAGE(PG8_SB(0, 0), cB, voffB); PG8_STAGE(PG8_SB(0, 1), cB + hstep, voffB); PG8_STAGE(PG8_SA(0, 0), cA, voffA); PG8_STAGE(PG8_SA(0, 1), cA + hstep, voffA);
        if (wr == 1) PG8_BAR;
        PG8_WAIT_V(2); PG8_BAR;
        PG8_STAGE(PG8_SB(1, 0), cB + kstep, voffB); PG8_STAGE(PG8_SA(1, 0), cA + kstep, voffA); PG8_STAGE(PG8_SB(1, 1), cB + hstep + kstep, voffB);
        PG8_WAIT_V(6); PG8_BAR;
    } else {
        PG8_STAGE(PG8_SB(0, 0), cB, voffB); PG8_STAGE(PG8_SA(0, 0), cA, voffA); PG8_STAGE(PG8_SB(0, 1), cB + hstep, voffB); PG8_STAGE(PG8_SA(0, 1), cA + hstep, voffA);
        if (wr == 1) PG8_BAR;
        PG8_WAIT_V(4); PG8_BAR;
        PG8_STAGE(PG8_SB(1, 0), cB + kstep, voffB); PG8_STAGE(PG8_SA(1, 0), cA + kstep, voffA); PG8_STAGE(PG8_SB(1, 1), cB + hstep + kstep, voffB);
        PG8_WAIT_V(6); PG8_BAR;
    }
    for (;;) {
        const bool has_next = S.next(ui + 1, nxt);
        const char* nA = has_next ? (const char*)g.A + (size_t)nxt.pm * tstep : cA; const char* nB = has_next ? (const char*)g.Bt + (size_t)nxt.pn * tstep : cB;
        for (int t = 0; t < nt; t += 2) {
            const bool last = (t == nt - 2);
            const char* a1 = cA + (size_t)(t + 1) * kstep;
            const char* a2 = last ? nA : cA + (size_t)(t + 2) * kstep; const char* b2 = last ? nB : cB + (size_t)(t + 2) * kstep;
            const char* a3 = a2 + kstep; const char* b3 = b2 + kstep;
            if (last && has_next) S.a_ready(nxt);
            if constexpr (SP2) {
            PG8_LDB(B0, 0, 0); PG8_LDB(B1, 0, 1); PG8_SCHED; PG8_LDA(At, 0, 0); PG8_STAGE(PG8_SA(1, 1), a1 + hstep, voffA);
            PG8_WAIT_V(8); PG8_WAIT_L(0); PG8_BAR; PG8_MMA(0, 0, At, B0); PG8_MMA(0, 1, At, B1); PG8_BAR; PG8_SCHED;
            PG8_LDA(At, 0, 1); PG8_STAGE(PG8_SB(0, 0), b2, voffB); PG8_STAGE(PG8_SB(0, 1), b2 + hstep, voffB); PG8_STAGE(PG8_SA(0, 0), a2, voffA);
            PG8_WAIT_V(8); PG8_WAIT_L(0); PG8_BAR; PG8_MMA(1, 0, At, B0); PG8_MMA(1, 1, At, B1); PG8_BAR; PG8_SCHED;
            PG8_LDB(B0, 1, 0); PG8_LDB(B1, 1, 1); PG8_SCHED; PG8_LDA(At, 1, 0); PG8_STAGE(PG8_SA(0, 1), a2 + hstep, voffA);
            PG8_WAIT_V(8); PG8_WAIT_L(0); PG8_BAR; PG8_MMA(0, 0, At, B0); PG8_MMA(0, 1, At, B1); PG8_BAR; PG8_SCHED;
            PG8_LDA(At, 1, 1); PG8_STAGE(PG8_SB(1, 0), b3, voffB); PG8_STAGE(PG8_SB(1, 1), b3 + hstep, voffB); PG8_STAGE(PG8_SA(1, 0), a3, voffA);
            PG8_WAIT_V(8); PG8_WAIT_L(0); PG8_BAR; PG8_MMA(1, 0, At, B0); PG8_MMA(1, 1, At, B1); PG8_BAR; PG8_SCHED;
            } else {
            PG8_LDB(B0, 0, 0); PG8_SCHED; PG8_LDA(At, 0, 0); PG8_STAGE(PG8_SA(1, 1), a1 + hstep, voffA);
            PG8_WAIT_L(8); PG8_BAR; PG8_WAIT_L(0); PG8_MMA(0, 0, At, B0); PG8_BAR; PG8_SCHED;
            PG8_LDB(B1, 0, 1); PG8_STAGE(PG8_SB(0, 0), b2, voffB);
            PG8_BAR; PG8_WAIT_L(0); PG8_MMA(0, 1, At, B1); PG8_BAR;
            PG8_LDA(At, 0, 1); PG8_STAGE(PG8_SA(0, 0), a2, voffA);
            PG8_BAR; PG8_WAIT_L(0); PG8_MMA(1, 0, At, B0); PG8_BAR; PG8_SCHED;
            PG8_STAGE(PG8_SB(0, 1), b2 + hstep, voffB);
            PG8_WAIT_V(6); PG8_BAR; PG8_MMA(1, 1, At, B1); PG8_BAR;
            PG8_LDB(B0, 1, 0); PG8_SCHED; PG8_LDA(At, 1, 0); PG8_STAGE(PG8_SA(0, 1), a2 + hstep, voffA);
            PG8_WAIT_L(8); PG8_BAR; PG8_WAIT_L(0); PG8_MMA(0, 0, At, B0); PG8_BAR; PG8_SCHED;
            PG8_LDB(B1, 1, 1); PG8_STAGE(PG8_SB(1, 0), b3, voffB);
            PG8_BAR; PG8_WAIT_L(0); PG8_MMA(0, 1, At, B1); PG8_BAR;
            PG8_LDA(At, 1, 1); PG8_STAGE(PG8_SA(1, 0), a3, voffA);
            PG8_BAR; PG8_WAIT_L(0); PG8_MMA(1, 0, At, B0); PG8_BAR; PG8_SCHED;
            PG8_STAGE(PG8_SB(1, 1), b3 + hstep, voffB);
            PG8_WAIT_V(6); PG8_BAR; PG8_MMA(1, 1, At, B1); PG8_BAR;
            }
        }
        if constexpr (ALIGN_EPI) { if (wr == 0) PG8_BAR; }
        if constexpr (!Epi::AFTER_DRAIN) { E(acc, cur, wr, wc, fr, fq); S.done(cur); }
        if (!has_next) break;
#pragma unroll
        for (int a = 0; a < 2; ++a)
#pragma unroll
            for (int b = 0; b < 2; ++b)
#pragma unroll
                for (int m = 0; m < 4; ++m)
#pragma unroll
                    for (int n = 0; n < 2; ++n) acc[a][b][m][n] = (f32x4){0.f, 0.f, 0.f, 0.f};
        cur = nxt; cA = nA; cB = nB; ++ui;
        if constexpr (ALIGN_EPI) { if (wr == 1) PG8_BAR; }
    }
    PG8_WAIT_V(0);
    if constexpr (!ALIGN_EPI) { if (wr == 0) PG8_BAR; }
    PG8_BAR;
    if constexpr (Epi::AFTER_DRAIN) { E.fused(acc, cur, wr, wc, fr, fq, lds, wid, lane); S.done(cur); }
#undef PG8_SA
#undef PG8_SB
#undef PG8_STAGE
#undef PG8_LDA
#undef PG8_LDB
#undef PG8_MMA
#undef PG8_WAIT_V
#undef PG8_WAIT_L
#undef PG8_BAR
#undef PG8_SCHED
}
}

#include <hip/hip_cooperative_groups.h>
namespace cg = cooperative_groups;
using pg8::bf16_t; using pg8::bf16x8; using pg8::f32x4; using pg8::u32x4; using pg8::Unit; using pg8::BM; using pg8::HALF;
#define LAS __attribute__((address_space(3)))
typedef unsigned u32x2 __attribute__((ext_vector_type(2)));
#define GAS __attribute__((address_space(1)))
#define GP(p) ((GAS __typeof__(*(p))*)(p))
__device__ __forceinline__ GAS unsigned char* opq(unsigned char* p) { asm volatile("" : "+s"(p)); return (GAS unsigned char*)p; }

typedef float f32x2_t __attribute__((ext_vector_type(2))); typedef __bf16 bf16x2_t __attribute__((ext_vector_type(2)));
__device__ __forceinline__ unsigned pkbf(float lo, float hi) { f32x2_t v = {lo, hi}; bf16x2_t b = __builtin_convertvector(v, bf16x2_t); return __builtin_bit_cast(unsigned, b); }

constexpr int D_MODEL = 1024, BATCH = 4, SEQ = 8192, DEPTH = 2, M = BATCH * SEQ;
constexpr int NSPLIT = 2, MH = M / NSPLIT, BPH = BATCH / NSPLIT;
constexpr int D_IN = 8464, N_MAIN = 5392, N_MAIN_PAD = 5632, D_FF = 4096;
constexpr float EPS = 1e-6f, LOG2E = 1.4426950408889634f, QSCALE = 0.125f * LOG2E;
constexpr int NTH = 512;

constexpr size_t MiB = 1u << 20;
constexpr size_t WS_CTL = 0, CTL_BYTES = 1 * MiB;
constexpr size_t WS_SS = 488 * MiB;
constexpr size_t WS_CS = 1 * MiB;
constexpr size_t WS_WIN = 3 * MiB, WS_WG = 14 * MiB, WS_WA = 20 * MiB, WS_WB = 21 * MiB, WS_WC = 22 * MiB, WS_WO = 24 * MiB, WS_W1 = 26 * MiB, WS_W2 = 34 * MiB;
constexpr size_t WS_XB = 44 * MiB;
constexpr size_t WS_UA = 108 * MiB, WS_UC = 180 * MiB, WS_UZ = 244 * MiB, WS_UAB = 276 * MiB, WS_GL = 277 * MiB, WS_LSE = 278 * MiB;
constexpr size_t WS_W = 280 * MiB, WS_QD = 312 * MiB, WS_KDT = 344 * MiB, WS_UT = 376 * MiB, WS_ATT = 408 * MiB, WS_YAP = 424 * MiB, WS_YB = 472 * MiB, WS_END = 498 * MiB;
constexpr size_t WS_O = WS_UC, WS_YA = WS_W, WS_YC = WS_QD, WS_MRG = WS_KDT, WS_GA = 108 * MiB, WS_GB = 140 * MiB  , WS_GC = WS_UT  , WS_MSCR = 204 * MiB  , WS_H1 = WS_UA;

struct Args {
    const float* x; const int* pos; const float* norm_mix; const float* w_in; const float* b_in; const float* conv_w; const float* a_log; const float* dt_bias;
    const float* sinks; const float* c_norm; const float* wba; const float* wbb; const float* wbc; const float* w_out; const float* norm_ffn; const float* w_ff1;
    const float* w_ff2; const float* norm_final; float* out; unsigned char* ws;
};

__device__ __forceinline__ float bf_lo(unsigned u) { return __uint_as_float(u << 16); }
__device__ __forceinline__ float bf_hi(unsigned u) { return __uint_as_float(u & 0xffff0000u); }
__device__ __forceinline__ float sigmoidf_(float v) { return 1.0f / (1.0f + __expf(-v)); }
__device__ __forceinline__ f32x4 mfma16(bf16x8 a, bf16x8 b, f32x4 c) { return __builtin_amdgcn_mfma_f32_16x16x32_bf16(a, b, c, 0, 0, 0); }

__device__ __forceinline__ float row_rstd(GAS const float* ssp, int r) {
    GAS const f32x4* p = (GAS const f32x4*)(ssp + (size_t)r * 16); const f32x4 a = p[0], b = p[1], c = p[2], d = p[3];
    const float t = (((a[0] + a[1]) + (a[2] + a[3])) + ((b[0] + b[1]) + (b[2] + b[3]))) + (((c[0] + c[1]) + (c[2] + c[3])) + ((d[0] + d[1]) + (d[2] + d[3])));
    return rsqrtf(t * (1.0f / D_MODEL) + EPS);
}
struct EpiG1 {
    static constexpr bool PERM = true, AFTER_DRAIN = false;
    GAS bf16_t*UA, *UC, *UZ; GAS float* UAB; GAS const float* bias; GAS const float* ss; GAS const float* cs;
    __device__ __forceinline__ void operator()(const f32x4 (&acc)[2][2][4][2], const Unit& u, int wr, int wc, int fr_in, int fq) const {
        int fr = fr_in; asm volatile("" : "+v"(fr));
        const int pn = u.pn; const int row0 = u.pm * BM + wr * 64 + fr; const int bcol0 = pn * BM + wc * 32 + 8 * fq;
        f32x4 bv[2][2];
#pragma unroll
        for (int bj = 0; bj < 2; ++bj)
#pragma unroll
            for (int n = 0; n < 2; ++n) bv[bj][n] = *(GAS const f32x4*)(bias + bcol0 + bj * HALF + 4 * n);
        if (pn == 21) {
            if (wc == 0 && fq < 2) {
#pragma unroll
                for (int ai = 0; ai < 2; ++ai)
#pragma unroll
                    for (int m = 0; m < 4; ++m) { const int r = row0 + ai * HALF + m * 16; const float rs = row_rstd(ss, r);
                        *(GAS f32x4*)(UAB + (size_t)r * 16 + 8 * fq) = acc[ai][0][m][0] * rs + bv[0][0]; *(GAS f32x4*)(UAB + (size_t)r * 16 + 8 * fq + 4) = acc[ai][0][m][1] * rs + bv[0][1]; }
            }
            return;
        }
        GAS bf16_t* base; int ldc, colt;
        if (pn < 9) { base = UA; ldc = 2304; colt = pn * 256; } else if (pn < 17) { base = UC; ldc = 2048; colt = (pn - 9) * 256; } else { base = UZ; ldc = 1024; colt = (pn - 17) * 256; }
        const int col0 = colt + wc * 32 + 8 * fq;
        const float qs = (pn < 2 || pn == 6 || pn == 7) ? QSCALE : 1.0f;
        const float sg = (fq == 0) ? -1.0f : 1.0f;
#pragma unroll
        for (int ai = 0; ai < 2; ++ai)
#pragma unroll
            for (int m = 0; m < 4; ++m) { const int r = row0 + ai * HALF + m * 16; const float rs = row_rstd(ss, r);
                GAS bf16_t* rowp = base + (size_t)r * ldc + col0;
#pragma unroll
                for (int bj = 0; bj < 2; ++bj) { f32x4 v0 = acc[ai][bj][m][0] * rs + bv[bj][0], v1 = acc[ai][bj][m][1] * rs + bv[bj][1];
                    const bool rope = ((wc & 1) == 0) && (pn < 4 || pn == 6 || pn == 7 || (pn == 8 && bj == 0));
                    if (rope) { f32x4 p0, p1;
#pragma unroll
                        for (int i = 0; i < 4; ++i) { p0[i] = __shfl_xor(v0[i], 16); p1[i] = __shfl_xor(v1[i], 16); }
                        if (fq < 2) { GAS const float* c = cs + (size_t)r * 16; const f32x4 c0 = *(GAS const f32x4*)c, c1 = *(GAS const f32x4*)(c + 4), s0 = *(GAS const f32x4*)(c + 8), s1 = *(GAS const f32x4*)(c + 12);
                            v0 = v0 * c0 + (p0 * s0) * sg; v1 = v1 * c1 + (p1 * s1) * sg; } }
                    v0 = v0 * qs; v1 = v1 * qs; u32x4 w; w.x = pkbf(v0[0], v0[1]); w.y = pkbf(v0[2], v0[3]); w.z = pkbf(v1[0], v1[1]); w.w = pkbf(v1[2], v1[3]);
                    *(GAS u32x4*)(rowp + bj * HALF) = w; }
                asm volatile("" ::: "memory"); }
    }
};
struct EpiGate {
    static constexpr bool PERM = true, AFTER_DRAIN = false;
    GAS bf16_t* O0; GAS const float* bias; GAS const float* ss;
    __device__ __forceinline__ void operator()(const f32x4 (&acc)[2][2][4][2], const Unit& u, int wr, int wc, int fr_in, int fq) const {
        int fr = fr_in; asm volatile("" : "+v"(fr));
        const int row0 = u.pm * BM + wr * 64 + fr; const int col0 = u.pn * BM + wc * 32 + 8 * fq; const int tb = u.pn >> 2; const int lcol0 = col0 - tb * 1024;
        GAS bf16_t* O = O0 + ((tb == 0) ? (size_t)0 : (tb == 1) ? (size_t)((WS_GB - WS_GA) / 2) : (size_t)((WS_GC - WS_GA) / 2));
        f32x4 bv[2][2];
#pragma unroll
        for (int bj = 0; bj < 2; ++bj)
#pragma unroll
            for (int n = 0; n < 2; ++n) bv[bj][n] = *(GAS const f32x4*)(bias + col0 + bj * HALF + 4 * n);
#pragma unroll
        for (int ai = 0; ai < 2; ++ai)
#pragma unroll
            for (int m = 0; m < 4; ++m) { const int r = row0 + ai * HALF + m * 16; const float rs = row_rstd(ss, r);
#pragma unroll
                for (int bj = 0; bj < 2; ++bj) { const f32x4 v0 = acc[ai][bj][m][0] * rs + bv[bj][0], v1 = acc[ai][bj][m][1] * rs + bv[bj][1]; u32x4 w;
                    w.x = pkbf(sigmoidf_(v0[0]), sigmoidf_(v0[1])); w.y = pkbf(sigmoidf_(v0[2]), sigmoidf_(v0[3]));
                    w.z = pkbf(sigmoidf_(v1[0]), sigmoidf_(v1[1])); w.w = pkbf(sigmoidf_(v1[2]), sigmoidf_(v1[3]));
                    *(GAS u32x4*)(O + (size_t)r * 1024 + lcol0 + bj * HALF) = w; }
                asm volatile("" ::: "memory"); }
    }
};
template <int MODE> struct EpiBranch {
    static constexpr bool PERM = true, AFTER_DRAIN = false;
    GAS const bf16_t* gates; GAS f32x4* mscr; GAS bf16_t* out;
    __device__ __forceinline__ void operator()(const f32x4 (&acc)[2][2][4][2], const Unit& u, int wr, int wc, int fr_in, int fq) const {
        int fr = fr_in; asm volatile("" : "+v"(fr));
        const int row0 = u.pm * BM + wr * 64 + fr; const int col0 = u.pn * BM + wc * 32 + 8 * fq; const int tid = (wr * 4 + wc) * 64 + fq * 16 + fr;
        GAS f32x4* ms = mscr + tid;
#pragma unroll
        for (int ai = 0; ai < 2; ++ai)
#pragma unroll
            for (int m = 0; m < 4; ++m) { const int r = row0 + ai * HALF + m * 16;
#pragma unroll
                for (int bj = 0; bj < 2; ++bj) { const u32x4 g = *(GAS const u32x4*)(gates + (size_t)r * 1024 + col0 + bj * HALF);
                    f32x4 v0 = acc[ai][bj][m][0] * (f32x4){bf_lo(g.x), bf_hi(g.x), bf_lo(g.y), bf_hi(g.y)}, v1 = acc[ai][bj][m][1] * (f32x4){bf_lo(g.z), bf_hi(g.z), bf_lo(g.w), bf_hi(g.w)};
                    if (MODE == 0) { ms[0] = v0; ms[NTH] = v1; }
                    else if (MODE == 1) { ms[0] = ms[0] + v0; ms[NTH] = ms[NTH] + v1; }
                    else { v0 = v0 + ms[0]; v1 = v1 + ms[NTH]; u32x4 w; w.x = pkbf(v0[0], v0[1]); w.y = pkbf(v0[2], v0[3]); w.z = pkbf(v1[0], v1[1]); w.w = pkbf(v1[2], v1[3]);
                        *(GAS u32x4*)(out + (size_t)r * D_MODEL + col0 + bj * HALF) = w; }
                    ms += 2 * NTH; asm volatile("" : "+v"(ms)); }
                asm volatile("" ::: "memory"); }
    }
};
struct EpiResid {
    static constexpr bool PERM = true, AFTER_DRAIN = false;
    GAS const float* base; GAS float* out; GAS bf16_t* xb; GAS float* ssout;
    __device__ __forceinline__ void operator()(const f32x4 (&acc)[2][2][4][2], const Unit& u, int wr, int wc, int fr_in, int fq) const {
        int fr = fr_in; asm volatile("" : "+v"(fr));
        const int row0 = u.pm * BM + wr * 64 + fr; const int col0 = u.pn * BM + wc * 32 + 8 * fq;
#pragma unroll
        for (int ai = 0; ai < 2; ++ai)
#pragma unroll
            for (int m = 0; m < 4; ++m) { const int r = row0 + ai * HALF + m * 16; float sq = 0.f;
#pragma unroll
                for (int bj = 0; bj < 2; ++bj) { const size_t off = (size_t)r * D_MODEL + col0 + bj * HALF;
                    const f32x4 v0 = acc[ai][bj][m][0] + *(GAS const f32x4*)(base + off), v1 = acc[ai][bj][m][1] + *(GAS const f32x4*)(base + off + 4);
                    *(GAS f32x4*)(out + off) = v0; *(GAS f32x4*)(out + off + 4) = v1;
                    u32x4 w; w.x = pkbf(v0[0], v0[1]); w.y = pkbf(v0[2], v0[3]); w.z = pkbf(v1[0], v1[1]); w.w = pkbf(v1[2], v1[3]);
                    *(GAS u32x4*)(xb + off) = w;
                    sq += (v0[0] * v0[0] + v0[1] * v0[1]) + (v0[2] * v0[2] + v0[3] * v0[3]) + (v1[0] * v1[0] + v1[1] * v1[1]) + (v1[2] * v1[2] + v1[3] * v1[3]); }
                sq += __shfl_xor(sq, 16); sq += __shfl_xor(sq, 32);
                if (fq == 0) ssout[(size_t)r * 16 + u.pn * 4 + wc] = sq;
                asm volatile("" ::: "memory"); }
    }
};
struct EpiRelu2 {
    static constexpr bool PERM = true, AFTER_DRAIN = false;
    GAS bf16_t* O; GAS const float* ss;
    __device__ __forceinline__ void operator()(const f32x4 (&acc)[2][2][4][2], const Unit& u, int wr, int wc, int fr_in, int fq) const {
        int fr = fr_in; asm volatile("" : "+v"(fr));
        const int row0 = u.pm * BM + wr * 64 + fr; const int col0 = u.pn * BM + wc * 32 + 8 * fq;
#pragma unroll
        for (int ai = 0; ai < 2; ++ai)
#pragma unroll
            for (int m = 0; m < 4; ++m) { const int r = row0 + ai * HALF + m * 16; const float rs = row_rstd(ss, r);
#pragma unroll
                for (int bj = 0; bj < 2; ++bj) { f32x4 v0 = acc[ai][bj][m][0] * rs, v1 = acc[ai][bj][m][1] * rs;
#pragma unroll
                    for (int i = 0; i < 4; ++i) { const float a = fmaxf(v0[i], 0.f), b = fmaxf(v1[i], 0.f); v0[i] = a * a; v1[i] = b * b; }
                    u32x4 w; w.x = pkbf(v0[0], v0[1]); w.y = pkbf(v0[2], v0[3]); w.z = pkbf(v1[0], v1[1]); w.w = pkbf(v1[2], v1[3]);
                    *(GAS u32x4*)(O + (size_t)r * D_FF + col0 + bj * HALF) = w; }
                asm volatile("" ::: "memory"); }
    }
};

__device__ __forceinline__ void transpose_item(GAS const float* W, int K, int ldw, int c0, int ncols, GAS const float* gain, GAS bf16_t* WT, LAS float* scr, int item, int lane) {
    const int nblk = (ncols + 31) / 32, kb = item / nblk, nb = item % nblk, k0 = 64 * kb, n0 = 32 * nb;
    const bool ok = (n0 + (lane & 31)) < ncols;
#pragma unroll 8
    for (int i = 0; i < 32; ++i) { const int kk = 2 * i + (lane >> 5); float v = 0.f; if (ok) { v = __builtin_nontemporal_load(W + (size_t)(k0 + kk) * ldw + c0 + n0 + (lane & 31)); if (gain) v *= gain[k0 + kk]; } scr[kk * 33 + (lane & 31)] = v; }
    asm volatile("s_waitcnt lgkmcnt(0)" ::: "memory");
    const int c = lane & 7;
#pragma unroll
    for (int j = 0; j < 4; ++j) { const int n = (lane >> 3) + 8 * j; const LAS float* s = scr + (8 * c) * 33 + n; u32x4 o;
        o.x = pkbf(s[0 * 33], s[1 * 33]); o.y = pkbf(s[2 * 33], s[3 * 33]); o.z = pkbf(s[4 * 33], s[5 * 33]); o.w = pkbf(s[6 * 33], s[7 * 33]);
        *(GAS u32x4*)(WT + (size_t)(n0 + n) * K + k0 + 8 * c) = o; }
    asm volatile("s_waitcnt lgkmcnt(0)" ::: "memory");
}
__device__ __forceinline__ void convert_weights(const Args& a, int layer, LAS unsigned char* lds, int gw, int ngw, int wave, int lane) {
    LAS float* scr = (LAS float*)(lds + wave * 8448);
    GAS unsigned char* ws = opq(a.ws);
    GAS const float* win = GP(a.w_in) + (size_t)layer * D_MODEL * D_IN; GAS const float* gmix = GP(a.norm_mix) + layer * D_MODEL; GAS const float* gffn = GP(a.norm_ffn) + layer * D_MODEL;
    constexpr int I_MAIN = 16 * 169, I_G = 16 * 96, I_A = 8 * 32, I_C = 16 * 32, I_1 = 16 * 128, I_2 = 64 * 32;
    constexpr int TOT = I_MAIN + I_G + 2 * I_A + 2 * I_C + I_1 + I_2;
    for (int it = gw; it < TOT; it += ngw) { int r = it;
        if (r < I_MAIN) { transpose_item(win, 1024, D_IN, 0, N_MAIN, gmix, (GAS bf16_t*)(ws + WS_WIN), scr, r, lane); continue; } r -= I_MAIN;
        if (r < I_G) { transpose_item(win, 1024, D_IN, N_MAIN, 3072, gmix, (GAS bf16_t*)(ws + WS_WG), scr, r, lane); continue; } r -= I_G;
        if (r < I_A) { transpose_item(GP(a.wba) + (size_t)layer * 512 * 1024, 512, 1024, 0, 1024, nullptr, (GAS bf16_t*)(ws + WS_WA), scr, r, lane); continue; } r -= I_A;
        if (r < I_A) { transpose_item(GP(a.wbb) + (size_t)layer * 512 * 1024, 512, 1024, 0, 1024, nullptr, (GAS bf16_t*)(ws + WS_WB), scr, r, lane); continue; } r -= I_A;
        if (r < I_C) { transpose_item(GP(a.wbc) + (size_t)layer * 1024 * 1024, 1024, 1024, 0, 1024, nullptr, (GAS bf16_t*)(ws + WS_WC), scr, r, lane); continue; } r -= I_C;
        if (r < I_C) { transpose_item(GP(a.w_out) + (size_t)layer * 1024 * 1024, 1024, 1024, 0, 1024, nullptr, (GAS bf16_t*)(ws + WS_WO), scr, r, lane); continue; } r -= I_C;
        if (r < I_1) { transpose_item(GP(a.w_ff1) + (size_t)layer * 1024 * 4096, 1024, 4096, 0, 4096, gffn, (GAS bf16_t*)(ws + WS_W1), scr, r, lane); continue; } r -= I_1;
        transpose_item(GP(a.w_ff2) + (size_t)layer * 4096 * 1024, 4096, 1024, 0, 1024, nullptr, (GAS bf16_t*)(ws + WS_W2), scr, r, lane);
    }
    { GAS u32x4* z = (GAS u32x4*)((GAS bf16_t*)(ws + WS_WIN) + (size_t)5408 * 1024); const int nz = (N_MAIN_PAD - 5408) * 1024 / 8;
      for (int i = gw * 64 + lane; i < nz; i += ngw * 64) z[i] = (u32x4){0u, 0u, 0u, 0u}; }
}

typedef short v4i16_t __attribute__((ext_vector_type(4)));
struct AttnRegs { u32x4 k[4], v[4]; bf16x8 q0, q1; };
struct AttnDesc { int cfg, bl, head, lg, res, nb, qcol, kcol, vcol; };
__device__ __forceinline__ AttnDesc attn_desc(int uid) {
    AttnDesc d; d.cfg = uid >> 10; d.bl = (uid >> 9) & 1; d.head = (uid >> 6) & 7; const int j = uid & 63;
    d.lg = (d.cfg == 1) ? 2 : ((d.cfg == 2) ? 4 : 0); d.res = j & ((1 << d.lg) - 1); d.nb = j >> d.lg;
    if (d.cfg < 3) { d.qcol = d.head * 64; d.kcol = 512 + d.head * 64; d.vcol = 1024 + d.head * 64; } else { d.qcol = 1536 + d.head * 64; d.kcol = 2048 + (d.head >> 2) * 64; d.vcol = 2176 + (d.head >> 2) * 64; }
    return d;
}
__device__ __forceinline__ void attn_load(AttnRegs& R, const AttnDesc& d, GAS const bf16_t* UA, int tid, int lane, int w, int l15, int g) {
    const size_t rowbase = (size_t)d.bl * SEQ; const int lg = d.lg;
#pragma unroll
    for (int it = 0; it < 4; ++it) { const int key = (tid >> 3) + 64 * it, ch = tid & 7; const int t = (d.nb - 1) * 128 + key; u32x4 v = (u32x4){0u, 0u, 0u, 0u};
        if (t >= 0) v = __builtin_nontemporal_load((GAS const u32x4*)(UA + (rowbase + ((size_t)t << lg) + d.res) * 2304 + d.kcol + ch * 8));
        R.k[it] = v; }
#pragma unroll
    for (int it = 0; it < 4; ++it) { const int key = (tid >> 3) + 64 * it, ch = tid & 7; const int t = (d.nb - 1) * 128 + key; u32x4 v = (u32x4){0u, 0u, 0u, 0u};
        if (t >= 0) v = __builtin_nontemporal_load((GAS const u32x4*)(UA + (rowbase + ((size_t)t << lg) + d.res) * 2304 + d.vcol + ch * 8));
        R.v[it] = v; }
    { const int tq = d.nb * 128 + 16 * w + l15; GAS const bf16_t* qp = UA + (rowbase + ((size_t)tq << lg) + d.res) * 2304 + d.qcol + 8 * g; R.q0 = __builtin_nontemporal_load((GAS const bf16x8*)qp); R.q1 = __builtin_nontemporal_load((GAS const bf16x8*)(qp + 32)); }
}
__device__ __forceinline__ void attn_stage(const AttnRegs& R, LAS unsigned char* lds, int tid, int lane, int w) {
    LAS bf16_t* Ks = (LAS bf16_t*)lds; LAS bf16_t* Vs = (LAS bf16_t*)(lds + 256 * 72 * 2);
#pragma unroll
    for (int it = 0; it < 4; ++it) { const int key = (tid >> 3) + 64 * it, ch = tid & 7; *(LAS u32x4*)(Ks + key * 72 + ch * 8) = R.k[it]; *(LAS u32x4*)(Vs + key * 72 + ch * 8) = R.v[it]; }
}
__device__ __forceinline__ void attn_compute(const AttnDesc& d, bf16x8 q0, bf16x8 q1, LAS unsigned char* lds, GAS bf16_t* YAP, GAS float* LSE, GAS bf16_t* YB, GAS const float* sinks, int w, int l15, int g) {
    const int cfg = d.cfg, lg = d.lg, res = d.res, nb = d.nb, head = d.head; const size_t rowbase = (size_t)d.bl * SEQ;
    const int maxd = (cfg == 3) ? 127 : 128;
    LAS bf16_t* Ks = (LAS bf16_t*)lds; LAS bf16_t* Vt = (LAS bf16_t*)(lds + 256 * 72 * 2);
    const int kt0 = w & ~1;
    f32x4 s[10];
#pragma unroll
    for (int hb = 0; hb < 2; ++hb) {
        bf16x8 ka[5][2];
#pragma unroll
        for (int t5 = 0; t5 < 5; ++t5) { const LAS bf16_t* kp = Ks + (16 * (kt0 + 5 * hb + t5) + l15) * 72 + 8 * g; ka[t5][0] = *(const LAS bf16x8*)kp; ka[t5][1] = *(const LAS bf16x8*)(kp + 32); }
        __builtin_amdgcn_sched_barrier(0);
#pragma unroll
        for (int t5 = 0; t5 < 5; ++t5) { s[5 * hb + t5] = mfma16(ka[t5][0], q0, (f32x4){0.f, 0.f, 0.f, 0.f}); s[5 * hb + t5] = mfma16(ka[t5][1], q1, s[5 * hb + t5]); }
        __builtin_amdgcn_sched_barrier(0); }
    const int ql = 16 * w + l15; float mx = -1e30f;
#pragma unroll
    for (int tt = 0; tt < 10; ++tt)
#pragma unroll
        for (int jj = 0; jj < 4; ++jj) { const int kj = 16 * (kt0 + tt) + 4 * g + jj; const int dist = 128 + ql - kj;
            const bool valid = (dist >= 0) && (dist <= maxd) && (nb > 0 || kj >= 128);
            const float v = valid ? s[tt][jj] : -1e30f; s[tt][jj] = v; mx = fmaxf(mx, v); }
    mx = fmaxf(mx, __shfl_xor(mx, 16)); mx = fmaxf(mx, __shfl_xor(mx, 32));
    float sk = -1e30f; if (cfg == 3) { sk = sinks[head] * LOG2E; mx = fmaxf(mx, sk); }
    float sum = 0.f;
#pragma unroll
    for (int tt = 0; tt < 10; ++tt)
#pragma unroll
        for (int jj = 0; jj < 4; ++jj) { const float p = __builtin_amdgcn_exp2f(s[tt][jj] - mx); s[tt][jj] = p; sum += p; }
    sum += __shfl_xor(sum, 16); sum += __shfl_xor(sum, 32);
    if (cfg == 3) sum += __builtin_amdgcn_exp2f(sk - mx);
    f32x4 o[4];
#pragma unroll
    for (int db = 0; db < 4; ++db) o[db] = (f32x4){0.f, 0.f, 0.f, 0.f};
#pragma unroll
    for (int pp = 0; pp < 5; ++pp) { u32x4 pw; pw.x = pkbf(s[2 * pp][0], s[2 * pp][1]); pw.y = pkbf(s[2 * pp][2], s[2 * pp][3]); pw.z = pkbf(s[2 * pp + 1][0], s[2 * pp + 1][1]); pw.w = pkbf(s[2 * pp + 1][2], s[2 * pp + 1][3]);
        const bf16x8 pf = __builtin_bit_cast(bf16x8, pw);
        v4i16_t lo[4], hi[4];
#pragma unroll
        for (int db = 0; db < 4; ++db) { const LAS bf16_t* vp = Vt + (16 * (kt0 + 2 * pp) + 4 * g + (l15 >> 2)) * 72 + 16 * db + 4 * (l15 & 3);
            lo[db] = __builtin_amdgcn_ds_read_tr16_b64_v4i16((LAS v4i16_t*)vp); hi[db] = __builtin_amdgcn_ds_read_tr16_b64_v4i16((LAS v4i16_t*)(vp + 16 * 72)); }
        __builtin_amdgcn_sched_barrier(0);
#pragma unroll
        for (int db = 0; db < 4; ++db) { const bf16x8 bw = (bf16x8){lo[db][0], lo[db][1], lo[db][2], lo[db][3], hi[db][0], hi[db][1], hi[db][2], hi[db][3]};
            o[db] = mfma16(bw, pf, o[db]); }
        __builtin_amdgcn_sched_barrier(0); }
    const float linv = 1.0f / sum;
    GAS bf16_t* obase = (cfg < 3) ? (YAP + (size_t)cfg * MH * 512) : YB;
    { const int tq = nb * 128 + 16 * w + l15; const size_t grow = rowbase + ((size_t)tq << lg) + res;
      GAS bf16_t* op = obase + grow * 512 + head * 64 + 4 * g;
#pragma unroll
      for (int db = 0; db < 4; ++db) { u32x2 pk; pk.x = pkbf(o[db][0] * linv, o[db][1] * linv); pk.y = pkbf(o[db][2] * linv, o[db][3] * linv); __builtin_nontemporal_store(pk, (GAS u32x2*)(op + 16 * db)); } }
    if (cfg < 3 && g == 0) { const int tq = nb * 128 + 16 * w + l15; const size_t grow = rowbase + ((size_t)tq << lg) + res; LSE[((size_t)cfg * MH + grow) * 8 + head] = mx + __builtin_amdgcn_logf(sum); }
}
#define LBAR() asm volatile("s_waitcnt lgkmcnt(0)\n\ts_barrier" ::: "memory")
__device__ __forceinline__ void attn_run(LAS unsigned char* lds, int u0, int stride, int nunits, GAS const bf16_t* UA, GAS bf16_t* YAP, GAS float* LSE, GAS bf16_t* YB, GAS const float* sinks) {
    int tid_l = threadIdx.x; asm volatile("" : "+v"(tid_l)); const int tid = tid_l, lane = tid & 63, w = __builtin_amdgcn_readfirstlane(tid >> 6), l15 = lane & 15, g = lane >> 4;
    if (u0 >= nunits) return;
    AttnRegs R; AttnDesc d = attn_desc(u0);
    attn_load(R, d, UA, tid, lane, w, l15, g);
    for (int u = u0; u < nunits; u += stride) {
        attn_stage(R, lds, tid, lane, w);
        const bf16x8 q0 = R.q0, q1 = R.q1; const AttnDesc dc = d;
        LBAR();
        if (u + stride < nunits) { d = attn_desc(u + stride); attn_load(R, d, UA, tid, lane, w, l15, g); }
        attn_compute(dc, q0, q1, lds, YAP, LSE, YB, sinks, w, l15, g);
        LBAR();
    }
}

__device__ __forceinline__ int frag16(int row, int k, int nkk) { return ((((row >> 4) * nkk + (k >> 5)) * 64 + ((k >> 3) & 3) * 16 + (row & 15)) << 3) + (k & 7); }
__device__ __forceinline__ void prep_unit(LAS unsigned char* lds, int item, GAS const bf16_t* UC, GAS const float* UAB, GAS const float* convw, GAS const float* a_log, GAS const float* dt_bias,
                                          GAS bf16_t* Wg, GAS bf16_t* QD, GAS bf16_t* KDT, GAS bf16_t* UT, GAS bf16_t* ATT, GAS float* GL) {
    int tid_l = threadIdx.x; asm volatile("" : "+v"(tid_l)); const int tid = tid_l, lane = tid & 63, w = __builtin_amdgcn_readfirstlane(tid >> 6), l15 = lane & 15, g = lane >> 4;
    const int n = item & 127, hv = (item >> 7) & 7, bl = item >> 10, hk = hv >> 1;
    const size_t row0 = (size_t)bl * SEQ + (size_t)n * 64;
    LAS bf16_t* Kb = (LAS bf16_t*)lds; LAS bf16_t* Qb = (LAS bf16_t*)(lds + 17408); LAS bf16_t* Vb = (LAS bf16_t*)(lds + 34816);
    LAS float* AT = (LAS float*)(lds + 52224); LAS bf16_t* Ab = (LAS bf16_t*)(lds + 69632); LAS bf16_t* XT = (LAS bf16_t*)(lds + 78848); LAS float* RB = (LAS float*)(lds + 115712);
    LAS float* gcs = (LAS float*)(lds + 132352); LAS float* betas = (LAS float*)(lds + 132608);
    GAS bf16_t* Wi = Wg + (size_t)item * 8192; GAS bf16_t* QDi = QD + (size_t)item * 8192; GAS bf16_t* KDTi = KDT + (size_t)item * 8192; GAS bf16_t* UTi = UT + (size_t)item * 8192; GAS bf16_t* ATTi = ATT + (size_t)item * 4096;
    if (w == 0) { const float ca = UAB[(row0 + lane) * 16 + hv], cb = UAB[(row0 + lane) * 16 + 8 + hv];
        const float xg = ca + dt_bias[hv]; const float sp = (xg > 20.f) ? xg : __logf(1.0f + __expf(xg)); float gg = -__expf(a_log[hv]) * sp;
#pragma unroll
        for (int off = 1; off < 64; off <<= 1) { const float t = __shfl_up(gg, off); if (lane >= off) gg += t; }
        gcs[lane] = gg; betas[lane] = sigmoidf_(cb); if (lane == 63) GL[item] = __expf(gg); }
    __syncthreads();
    { const int ch = tid & 15, r = tid >> 4;
      u32x4 xv[3][5]; f32x4 cw[3][4][2];
#pragma unroll
      for (int tz = 0; tz < 3; ++tz) { const int col = ((tz == 0) ? hk * 128 : (tz == 1) ? 512 + hk * 128 : 1024 + hv * 128) + 8 * ch;
#pragma unroll
        for (int jt = 0; jt < 5; ++jt) { const int sp = n * 64 + 2 * r - 3 + jt; const int spc = sp < 0 ? 0 : sp;
            u32x4 v = *(GAS const u32x4*)(UC + ((size_t)bl * SEQ + spc) * 2048 + col); if (sp < 0) v = (u32x4){0u, 0u, 0u, 0u}; xv[tz][jt] = v; }
#pragma unroll
        for (int jt = 0; jt < 4; ++jt) { cw[tz][jt][0] = *(GAS const f32x4*)(convw + jt * 2048 + col); cw[tz][jt][1] = *(GAS const f32x4*)(convw + jt * 2048 + col + 4); } }
#pragma unroll
      for (int tz = 0; tz < 3; ++tz) {
#pragma unroll
        for (int rh = 0; rh < 2; ++rh) { const int rr = 2 * r + rh;
            float y[8];
#pragma unroll
            for (int i = 0; i < 8; ++i) y[i] = 0.f;
#pragma unroll
            for (int jt = 0; jt < 4; ++jt) { const u32x4 x = xv[tz][rh + jt]; const f32x4 w0 = cw[tz][jt][0], w1 = cw[tz][jt][1];
                y[0] += bf_lo(x.x) * w0[0]; y[1] += bf_hi(x.x) * w0[1]; y[2] += bf_lo(x.y) * w0[2]; y[3] += bf_hi(x.y) * w0[3];
                y[4] += bf_lo(x.z) * w1[0]; y[5] += bf_hi(x.z) * w1[1]; y[6] += bf_lo(x.w) * w1[2]; y[7] += bf_hi(x.w) * w1[3]; }
#pragma unroll
            for (int i = 0; i < 8; ++i) y[i] = y[i] * sigmoidf_(y[i]);
            if (tz < 2) { float ssq = 0.f;
#pragma unroll
                for (int i = 0; i < 8; ++i) ssq += y[i] * y[i];
                ssq += __shfl_xor(ssq, 1); ssq += __shfl_xor(ssq, 2); ssq += __shfl_xor(ssq, 4); ssq += __shfl_xor(ssq, 8);
                float rn = rsqrtf(ssq + EPS); if (tz == 0) rn *= 0.08838834764831845f;
#pragma unroll
                for (int i = 0; i < 8; ++i) y[i] *= rn; }
            u32x4 pk; pk.x = pkbf(y[0], y[1]); pk.y = pkbf(y[2], y[3]); pk.z = pkbf(y[4], y[5]); pk.w = pkbf(y[6], y[7]);
            LAS bf16_t* dst = (tz == 0) ? Qb : (tz == 1) ? Kb : Vb;
            *(LAS u32x4*)(dst + rr * 136 + 8 * ch) = pk;
            if (tz == 0) { const float e = __expf(gcs[rr]); u32x4 qd; qd.x = pkbf(y[0] * e, y[1] * e); qd.y = pkbf(y[2] * e, y[3] * e); qd.z = pkbf(y[4] * e, y[5] * e); qd.w = pkbf(y[6] * e, y[7] * e);
                __builtin_nontemporal_store(qd, (GAS u32x4*)(QDi + frag16(rr, 8 * ch, 4))); } } } }
    __syncthreads();
    { const int rt = w & 3;
#pragma unroll
      for (int cc = 0; cc < 2; ++cc) { const int ct = 2 * (w >> 2) + cc;
        f32x4 d1 = (f32x4){0.f, 0.f, 0.f, 0.f}, d2 = (f32x4){0.f, 0.f, 0.f, 0.f};
        bf16x8 ka[4], kb2[4], qb2[4];
#pragma unroll
        for (int kk = 0; kk < 4; ++kk) { ka[kk] = *(const LAS bf16x8*)(Kb + (16 * rt + l15) * 136 + 32 * kk + 8 * g); kb2[kk] = *(const LAS bf16x8*)(Kb + (16 * ct + l15) * 136 + 32 * kk + 8 * g);
                                         qb2[kk] = *(const LAS bf16x8*)(Qb + (16 * ct + l15) * 136 + 32 * kk + 8 * g); }
        __builtin_amdgcn_sched_barrier(0);
#pragma unroll
        for (int kk = 0; kk < 4; ++kk) { d1 = mfma16(ka[kk], kb2[kk], d1); d2 = mfma16(ka[kk], qb2[kk], d2); }
        { const int jx = 16 * ct + l15; const float gj = gcs[jx]; f32x4 o;
#pragma unroll
          for (int jj = 0; jj < 4; ++jj) { const int c = 16 * rt + 4 * g + jj; o[jj] = (jx < c) ? d1[jj] * __expf(gcs[c] - gj) * betas[c] : 0.f; }
          *(LAS f32x4*)(AT + jx * 68 + 16 * rt + 4 * g) = o;
          const unsigned p01 = pkbf(o[0], o[1]), p23 = pkbf(o[2], o[3]);
          Ab[(16 * rt + 4 * g + 0) * 72 + jx] = (bf16_t)(p01 & 0xffffu); Ab[(16 * rt + 4 * g + 1) * 72 + jx] = (bf16_t)(p01 >> 16);
          Ab[(16 * rt + 4 * g + 2) * 72 + jx] = (bf16_t)(p23 & 0xffffu); Ab[(16 * rt + 4 * g + 3) * 72 + jx] = (bf16_t)(p23 >> 16); }
        { const int c = 16 * ct + l15; const float gc = gcs[c]; float o[4];
#pragma unroll
          for (int jj = 0; jj < 4; ++jj) { const int jx = 16 * rt + 4 * g + jj; o[jj] = (jx <= c) ? d2[jj] * __expf(gc - gcs[jx]) : 0.f; }
          u32x2 pk; pk.x = pkbf(o[0], o[1]); pk.y = pkbf(o[2], o[3]);
          __builtin_nontemporal_store(pk, (GAS u32x2*)(ATTi + frag16(c, 16 * rt + 4 * g, 2))); } } }
    __syncthreads();
    int vz; asm volatile("v_mov_b32 %0, 0" : "=v"(vz));
    const LAS float* ATz = AT + vz;
    LAS bf16_t* Tb = (LAS bf16_t*)(lds + 115712);
    LAS bf16_t* TM = (LAS bf16_t*)(lds + 115712 + 2048);
    if (tid < 64) { const int blk = tid >> 4, col = tid & 15; float r[16];
#pragma unroll
        for (int c = 0; c < 16; ++c) r[c] = (c == col) ? 1.f : 0.f;
#pragma unroll
        for (int jx = 0; jx < 15; ++jx) { const float xj = r[jx];
#pragma unroll
            for (int c = jx + 1; c < 16; ++c) r[c] -= ATz[(16 * blk + jx) * 68 + 16 * blk + c] * xj; }
#pragma unroll
        for (int c = 0; c < 16; ++c) Tb[(16 * blk + c) * 16 + col] = (bf16_t)(pkbf(r[c], 0.f) & 0xffffu);
    } else if (tid >= 256) { const int t2 = tid - 256, dk = t2 & 127, hf = t2 >> 7; const LAS float* gz = gcs + vz; const float gl = gz[63];
#pragma unroll
        for (int q = 0; q < 4; ++q) { float v[8];
#pragma unroll
            for (int e = 0; e < 8; ++e) { const int c = 32 * hf + 8 * q + e; v[e] = bf_lo((unsigned)Kb[c * 136 + dk]) * __expf(gl - gz[c]); }
            u32x4 pk; pk.x = pkbf(v[0], v[1]); pk.y = pkbf(v[2], v[3]); pk.z = pkbf(v[4], v[5]); pk.w = pkbf(v[6], v[7]);
            __builtin_nontemporal_store(pk, (GAS u32x4*)(KDTi + frag16(dk, 32 * hf + 8 * q, 2))); } }
    __syncthreads();
#pragma unroll
    for (int i = 0; i < 4; ++i) {
        u32x4 tf = (u32x4){0u, 0u, 0u, 0u}; if (g < 2) tf = *(const LAS u32x4*)(Tb + (16 * i + l15) * 16 + 8 * g);
        f32x4 acc[2]; float rh[2][4];
        u32x4 af[2], bfv[2][2];
#pragma unroll
        for (int kk = 0; kk < 2; ++kk) { af[kk] = (u32x4){0u, 0u, 0u, 0u};
#pragma unroll
            for (int tt = 0; tt < 2; ++tt) bfv[tt][kk] = (u32x4){0u, 0u, 0u, 0u};
            if (32 * kk < 16 * i) { const bool keep = (32 * kk + 8 * g) < 16 * i;
                u32x4 a_ = *(const LAS u32x4*)(Ab + (16 * i + l15) * 72 + 32 * kk + 8 * g); if (keep) af[kk] = a_;
#pragma unroll
                for (int tt = 0; tt < 2; ++tt) { u32x4 b_ = *(const LAS u32x4*)(XT + (16 * (2 * w + tt) + l15) * 72 + 32 * kk + 8 * g); if (keep) bfv[tt][kk] = b_; } } }
#pragma unroll
        for (int tt = 0; tt < 2; ++tt) { const int t = 2 * w + tt; const int nn = 16 * t + l15;
#pragma unroll
            for (int jj = 0; jj < 4; ++jj) { const int c = 16 * i + 4 * g + jj;
                if (t < 8) rh[tt][jj] = bf_lo((unsigned)Vb[c * 136 + nn]) * betas[c]; else rh[tt][jj] = bf_lo((unsigned)Kb[c * 136 + nn - 128]) * betas[c] * __expf(gcs[c]); } }
        __builtin_amdgcn_sched_barrier(0);
#pragma unroll
        for (int tt = 0; tt < 2; ++tt) { acc[tt] = (f32x4){0.f, 0.f, 0.f, 0.f};
#pragma unroll
            for (int kk = 0; kk < 2; ++kk) if (32 * kk < 16 * i) acc[tt] = mfma16(__builtin_bit_cast(bf16x8, af[kk]), __builtin_bit_cast(bf16x8, bfv[tt][kk]), acc[tt]); }
#pragma unroll
        for (int tt = 0; tt < 2; ++tt) { const int nn = 16 * (2 * w + tt) + l15; u32x2 pk; pk.x = pkbf(rh[tt][0] - acc[tt][0], rh[tt][1] - acc[tt][1]); pk.y = pkbf(rh[tt][2] - acc[tt][2], rh[tt][3] - acc[tt][3]);
            *(LAS u32x2*)(TM + nn * 24 + 4 * g) = pk; }
        asm volatile("s_waitcnt lgkmcnt(0)" ::: "memory");
        u32x4 bm[2];
#pragma unroll
        for (int tt = 0; tt < 2; ++tt) { const int nn = 16 * (2 * w + tt) + l15; bm[tt] = (u32x4){0u, 0u, 0u, 0u}; if (g < 2) bm[tt] = *(const LAS u32x4*)(TM + nn * 24 + 8 * g); }
#pragma unroll
        for (int tt = 0; tt < 2; ++tt) { const int t = 2 * w + tt; const int nn = 16 * t + l15;
            const f32x4 x = mfma16(__builtin_bit_cast(bf16x8, tf), __builtin_bit_cast(bf16x8, bm[tt]), (f32x4){0.f, 0.f, 0.f, 0.f});
            const unsigned x01 = pkbf(x[0], x[1]), x23 = pkbf(x[2], x[3]);
            *(LAS u32x2*)(XT + nn * 72 + 16 * i + 4 * g) = (u32x2){x01, x23};
            if (t < 8) { __builtin_nontemporal_store((u32x2){x01, x23}, (GAS u32x2*)(UTi + (((t * 4 + i) * 64 + g * 16 + l15) << 2)));
            } else { const int dk = nn - 128; GAS bf16_t* wp = Wi + frag16(16 * i + 4 * g, dk, 4);
                wp[0] = (bf16_t)(x01 & 0xffffu); wp[8] = (bf16_t)(x01 >> 16); wp[16] = (bf16_t)(x23 & 0xffffu); wp[24] = (bf16_t)(x23 >> 16); } }
        asm volatile("s_waitcnt lgkmcnt(0)" ::: "memory");
    }
    __syncthreads();
}

struct ScanFrags { bf16x8 m[4]; bf16x8 x[2]; bf16x8 kf[2]; u32x2 uf[2]; float gl; };
__device__ __forceinline__ void scan_load(ScanFrags& f, int item, int w, int lane, int dvb, GAS const bf16_t* Wg, GAS const bf16_t* QD, GAS const bf16_t* KDT, GAS const bf16_t* UT, GAS const bf16_t* ATT, GAS const float* GL) {
    const int rt = w & 3;
    GAS const bf16_t* mb = ((w < 4) ? Wg : QD) + (size_t)item * 8192 + (rt * 4) * 512 + lane * 8;
#pragma unroll
    for (int kk = 0; kk < 4; ++kk) f.m[kk] = *(GAS const bf16x8*)(mb + kk * 512);
    if (w < 4) {
#pragma unroll
        for (int ct = 0; ct < 2; ++ct) f.uf[ct] = *(GAS const u32x2*)(UT + (size_t)item * 8192 + (((dvb * 2 + ct) * 4 + rt) * 64 + lane) * 4);
    } else {
#pragma unroll
        for (int kk = 0; kk < 2; ++kk) f.x[kk] = *(GAS const bf16x8*)(ATT + (size_t)item * 4096 + ((rt * 2 + kk) * 64 + lane) * 8);
    }
#pragma unroll
    for (int kk = 0; kk < 2; ++kk) f.kf[kk] = *(GAS const bf16x8*)(KDT + (size_t)item * 8192 + ((w * 2 + kk) * 64 + lane) * 8);
    f.gl = GL[item];
}
__device__ __forceinline__ void scan_step(const ScanFrags& f, int n, int bl, int hv, int dvb, int w, int l15, int g, LAS bf16_t* STc, LAS bf16_t* STn, LAS bf16_t* VNT, f32x4 (&S)[2], GAS bf16_t* O) {
    const int rt = w & 3;
    f32x4 acc[2];
#pragma unroll
    for (int ct = 0; ct < 2; ++ct) { acc[ct] = (f32x4){0.f, 0.f, 0.f, 0.f};
#pragma unroll
        for (int kk = 0; kk < 4; ++kk) { const bf16x8 sb = *(const LAS bf16x8*)(STc + (16 * ct + l15) * 136 + 32 * kk + 8 * g); acc[ct] = mfma16(f.m[kk], sb, acc[ct]); } }
    if (w < 4) {
#pragma unroll
        for (int ct = 0; ct < 2; ++ct) { const float v0 = bf_lo(f.uf[ct].x) - acc[ct][0], v1 = bf_hi(f.uf[ct].x) - acc[ct][1], v2 = bf_lo(f.uf[ct].y) - acc[ct][2], v3 = bf_hi(f.uf[ct].y) - acc[ct][3];
            u32x2 pk; pk.x = pkbf(v0, v1); pk.y = pkbf(v2, v3); *(LAS u32x2*)(VNT + (16 * ct + l15) * 72 + 16 * rt + 4 * g) = pk; }
    }
    LBAR();
    if (w >= 4) {
#pragma unroll
        for (int ct = 0; ct < 2; ++ct) {
#pragma unroll
            for (int kk = 0; kk < 2; ++kk) { const bf16x8 vb = *(const LAS bf16x8*)(VNT + (16 * ct + l15) * 72 + 32 * kk + 8 * g); acc[ct] = mfma16(f.x[kk], vb, acc[ct]); }
            GAS bf16_t* op = O + ((size_t)bl * SEQ + (size_t)n * 64 + 16 * rt + 4 * g) * 1024 + hv * 128 + 32 * dvb + 16 * ct + l15;
            const unsigned o01 = pkbf(acc[ct][0], acc[ct][1]), o23 = pkbf(acc[ct][2], acc[ct][3]);
            op[0] = (bf16_t)(o01 & 0xffffu); op[1024] = (bf16_t)(o01 >> 16); op[2048] = (bf16_t)(o23 & 0xffffu); op[3072] = (bf16_t)(o23 >> 16); }
    }
#pragma unroll
    for (int c2 = 0; c2 < 2; ++c2) { f32x4 as = S[c2] * f.gl;
#pragma unroll
        for (int kk = 0; kk < 2; ++kk) { const bf16x8 vb = *(const LAS bf16x8*)(VNT + (16 * c2 + l15) * 72 + 32 * kk + 8 * g); as = mfma16(f.kf[kk], vb, as); }
        S[c2] = as; u32x2 pk; pk.x = pkbf(as[0], as[1]); pk.y = pkbf(as[2], as[3]);
        *(LAS u32x2*)(STn + (16 * c2 + l15) * 136 + 16 * w + 4 * g) = pk; }
    LBAR();
}
__device__ __forceinline__ void scan_unit(LAS unsigned char* lds, int unit, GAS const bf16_t* Wg, GAS const bf16_t* QD, GAS const bf16_t* KDT, GAS const bf16_t* UT, GAS const bf16_t* ATT, GAS const float* GL, GAS bf16_t* O) {
    int tid_l = threadIdx.x; asm volatile("" : "+v"(tid_l)); const int tid = tid_l, lane = tid & 63, w = __builtin_amdgcn_readfirstlane(tid >> 6), l15 = lane & 15, g = lane >> 4;
    const int dvb = unit & 3, hv = (unit >> 2) & 7, bl = unit >> 5; const int item0 = (bl * 8 + hv) * 128;
    LAS bf16_t* ST0 = (LAS bf16_t*)lds; LAS bf16_t* ST1 = (LAS bf16_t*)(lds + 8704); LAS bf16_t* VNT = (LAS bf16_t*)(lds + 17408);
    for (int i = tid; i < 8704 / 4; i += NTH) ((LAS unsigned*)lds)[i] = 0u;
    f32x4 S[2]; S[0] = (f32x4){0.f, 0.f, 0.f, 0.f}; S[1] = (f32x4){0.f, 0.f, 0.f, 0.f};
    __syncthreads();
    ScanFrags f0, f1, f2;
#define SLD(F, N) scan_load(F, item0 + (N), w, lane, dvb, Wg, QD, KDT, UT, ATT, GL)
#define SST(F, N) scan_step(F, (N), bl, hv, dvb, w, l15, g, ((N) & 1) ? ST1 : ST0, ((N) & 1) ? ST0 : ST1, VNT, S, O)
    SLD(f0, 0); SLD(f1, 1);
    for (int n = 0; n < 126; n += 3) {
        SLD(f2, n + 2); SST(f0, n);
        SLD(f0, n + 3); SST(f1, n + 1);
        SLD(f1, n + 4); SST(f2, n + 2);
    }
    SST(f0, 126); SST(f1, 127);
#undef SLD
#undef SST
}

#ifndef REP_G1
#define REP_G1 1
#endif
#ifndef REP_MIX1
#define REP_MIX1 1
#endif
#ifndef REP_MIX2
#define REP_MIX2 1
#endif
#ifndef REP_POST
#define REP_POST 1
#endif
#ifndef REP_BR
#define REP_BR 1
#endif
#ifndef REP_FF1
#define REP_FF1 1
#endif
#ifndef REP_CONV
#define REP_CONV 1
#endif
constexpr int LDS_CTL = 134144, LDS_BYTES = 135168;
__device__ __forceinline__ int next_item(GAS unsigned* ctr, LAS int* slot) {
    if (threadIdx.x == 0) *slot = (int)__hip_atomic_fetch_add(ctr, 1u, __ATOMIC_RELAXED, __HIP_MEMORY_SCOPE_AGENT);
    __syncthreads(); const int v = *slot; __syncthreads(); return v;
}
__device__ __forceinline__ float wave_sum(float v) {
#pragma unroll
    for (int o = 1; o < 64; o <<= 1) v += __shfl_xor(v, o);
    return v;
}


#define TIDS() int tid_l = threadIdx.x; asm volatile("" : "+v"(tid_l)); const int tid = tid_l, lane = tid & 63, wave = __builtin_amdgcn_readfirstlane(tid >> 6); \
    const int G = gridDim.x, bid = blockIdx.x; const int gw = bid * 8 + wave, ngw = G * 8; const int gt = bid * NTH + tid, ngt = G * NTH; (void)lane; (void)gw; (void)ngw; (void)gt; (void)ngt

__device__ __forceinline__ void phase_p0(const Args& a) {
    TIDS(); GAS unsigned char* ws = opq(a.ws);
    GAS float* ssb = (GAS float*)(ws + WS_SS); GAS float* cs = (GAS float*)(ws + WS_CS); GAS bf16_t* XB = (GAS bf16_t*)(ws + WS_XB);
    for (int m = gw; m < M; m += ngw) { GAS const f32x4* xr = (GAS const f32x4*)(GP(a.x) + (size_t)m * D_MODEL) + lane; float s = 0.f; GAS u32x2* o8 = (GAS u32x2*)(XB + (size_t)m * D_MODEL) + lane;
#pragma unroll
        for (int j = 0; j < 4; ++j) { const f32x4 v = __builtin_nontemporal_load(xr + 64 * j); s += (v[0] * v[0] + v[1] * v[1]) + (v[2] * v[2] + v[3] * v[3]); u32x2 pk; pk.x = pkbf(v[0], v[1]); pk.y = pkbf(v[2], v[3]); o8[64 * j] = pk; }
        s = wave_sum(s); if (lane < 16) ssb[(size_t)m * 16 + lane] = (lane == 0) ? s : 0.f; }
    for (int e = gt; e < M * 8; e += ngt) { const int m = e >> 3, i = e & 7;
        const double fr = (i == 0) ? 1.0 : (i == 1) ? 0.19392274474868576 : (i == 2) ? 0.03760603093086393 : (i == 3) ? 0.007292664737217109 : (i == 4) ? 0.001414213562373095
                        : (i == 5) ? 0.0002742481756762073 : (i == 6) ? 5.318295896944988e-05 : 1.031338537721246e-05;
        const double t = (double)GP(a.pos)[m] * fr * 0.15915494309189535; const float tf = (float)(t - floor(t));
        cs[(size_t)m * 16 + i] = __builtin_amdgcn_cosf(tf); cs[(size_t)m * 16 + 8 + i] = __builtin_amdgcn_sinf(tf); }
}
__device__ __forceinline__ void phase_conv(const Args& a, int layer, LAS unsigned char* lds) { TIDS(); convert_weights(a, layer, lds, gw, ngw, wave, lane); }

__device__ __forceinline__ void phase_g1(const Args& a, int layer, int hf, LAS unsigned char* lds) {
    GAS unsigned char* ws = opq(a.ws); const size_t r0 = (size_t)hf * MH; const int G = gridDim.x, bid = blockIdx.x;
    pg8::Gemm gm{(const bf16_t*)(ws + WS_XB) + r0 * D_MODEL, (const bf16_t*)(ws + WS_WIN), MH, N_MAIN_PAD, D_MODEL}; pg8::StaticOrder S; S.init(MH, N_MAIN_PAD, G, bid);
    EpiG1 E{(GAS bf16_t*)(ws + WS_UA), (GAS bf16_t*)(ws + WS_UC), (GAS bf16_t*)(ws + WS_UZ), (GAS float*)(ws + WS_UAB), GP(a.b_in) + (size_t)layer * D_IN, (GAS const float*)(ws + WS_SS) + ((size_t)(2 * layer) * M + r0) * 16, (GAS const float*)(ws + WS_CS) + r0 * 16};
    pg8::gemm_phase<EpiG1, pg8::StaticOrder, true, true>(lds, gm, S, E);
}
__device__ __forceinline__ void phase_mix(const Args& a, int layer, int hf, int which, LAS unsigned char* lds, int rep = 0) {
    GAS unsigned char* ws = opq(a.ws); const int bid = blockIdx.x, G = gridDim.x; (void)hf; (void)rep;
    GAS const bf16_t* UA = (GAS const bf16_t*)(ws + WS_UA); GAS bf16_t* YAP = (GAS bf16_t*)(ws + WS_YAP); GAS float* LSE = (GAS float*)(ws + WS_LSE); GAS bf16_t* YB = (GAS bf16_t*)(ws + WS_YB);
    GAS bf16_t* Wg = (GAS bf16_t*)(ws + WS_W); GAS bf16_t* QD = (GAS bf16_t*)(ws + WS_QD); GAS bf16_t* KDT = (GAS bf16_t*)(ws + WS_KDT); GAS bf16_t* UT = (GAS bf16_t*)(ws + WS_UT); GAS bf16_t* ATT = (GAS bf16_t*)(ws + WS_ATT); GAS float* GL = (GAS float*)(ws + WS_GL);
    if (which == 0) {
        for (int it = bid; it < 2048; it += G)
            prep_unit(lds, it, (GAS const bf16_t*)(ws + WS_UC), (GAS const float*)(ws + WS_UAB), GP(a.conv_w) + (size_t)layer * 4 * 2048, GP(a.a_log) + layer * 8, GP(a.dt_bias) + layer * 8, Wg, QD, KDT, UT, ATT, GL);
    } else {
        if (bid < 64 && G > 64) { const int xq = bid >> 3; const int sq = (bid & 7) + 8 * (xq >> 2);
            scan_unit(lds, sq * 4 + (xq & 3), Wg, QD, KDT, UT, ATT, GL, (GAS bf16_t*)(ws + WS_O));
        } else attn_run(lds, bid - 64, G - 64, 4096, UA, YAP, LSE, YB, GP(a.sinks) + layer * 8);
    }
}
__device__ __forceinline__ void phase_post(const Args& a, int layer) {
    TIDS(); GAS unsigned char* ws = opq(a.ws);
    GAS const float* LSE = (GAS const float*)(ws + WS_LSE); GAS const bf16_t* YAP = (GAS const bf16_t*)(ws + WS_YAP); GAS bf16_t* YA = (GAS bf16_t*)(ws + WS_YA);
    for (int e = gt; e < MH * 64; e += ngt) { const int row = e >> 6, ch = e & 63, head = ch >> 3;
        const float l0 = LSE[((size_t)0 * MH + row) * 8 + head], l1 = LSE[((size_t)1 * MH + row) * 8 + head], l2 = LSE[((size_t)2 * MH + row) * 8 + head];
        const float mx = fmaxf(l0, fmaxf(l1, l2)); float w0 = __builtin_amdgcn_exp2f(l0 - mx), w1 = __builtin_amdgcn_exp2f(l1 - mx), w2 = __builtin_amdgcn_exp2f(l2 - mx);
        const float inv = 1.0f / (w0 + w1 + w2); w0 *= inv; w1 *= inv; w2 *= inv;
        const u32x4 p0 = __builtin_nontemporal_load((GAS const u32x4*)(YAP + ((size_t)0 * MH + row) * 512 + ch * 8)), p1 = __builtin_nontemporal_load((GAS const u32x4*)(YAP + ((size_t)1 * MH + row) * 512 + ch * 8)), p2 = __builtin_nontemporal_load((GAS const u32x4*)(YAP + ((size_t)2 * MH + row) * 512 + ch * 8));
        u32x4 o;
        o.x = pkbf(w0 * bf_lo(p0.x) + w1 * bf_lo(p1.x) + w2 * bf_lo(p2.x), w0 * bf_hi(p0.x) + w1 * bf_hi(p1.x) + w2 * bf_hi(p2.x));
        o.y = pkbf(w0 * bf_lo(p0.y) + w1 * bf_lo(p1.y) + w2 * bf_lo(p2.y), w0 * bf_hi(p0.y) + w1 * bf_hi(p1.y) + w2 * bf_hi(p2.y));
        o.z = pkbf(w0 * bf_lo(p0.z) + w1 * bf_lo(p1.z) + w2 * bf_lo(p2.z), w0 * bf_hi(p0.z) + w1 * bf_hi(p1.z) + w2 * bf_hi(p2.z));
        o.w = pkbf(w0 * bf_lo(p0.w) + w1 * bf_lo(p1.w) + w2 * bf_lo(p2.w), w0 * bf_hi(p0.w) + w1 * bf_hi(p1.w) + w2 * bf_hi(p2.w));
        *(GAS u32x4*)(YA + (size_t)row * 512 + ch * 8) = o; }
    GAS const float* cn = GP(a.c_norm) + layer * 128; GAS const bf16_t* Ob = (GAS const bf16_t*)(ws + WS_O); GAS const bf16_t* UZ = (GAS const bf16_t*)(ws + WS_UZ); GAS bf16_t* YC = (GAS bf16_t*)(ws + WS_YC);
    for (int e = gt; e < MH * 128; e += ngt) { const int row = e >> 7, ch = e & 127, d0 = (ch & 15) * 8;
        const u32x4 ov = __builtin_nontemporal_load((GAS const u32x4*)(Ob + (size_t)row * 1024 + ch * 8)); const f32x4 o0 = (f32x4){bf_lo(ov.x), bf_hi(ov.x), bf_lo(ov.y), bf_hi(ov.y)}, o1 = (f32x4){bf_lo(ov.z), bf_hi(ov.z), bf_lo(ov.w), bf_hi(ov.w)};
        float sq = (o0[0] * o0[0] + o0[1] * o0[1]) + (o0[2] * o0[2] + o0[3] * o0[3]) + (o1[0] * o1[0] + o1[1] * o1[1]) + (o1[2] * o1[2] + o1[3] * o1[3]);
        sq += __shfl_xor(sq, 1); sq += __shfl_xor(sq, 2); sq += __shfl_xor(sq, 4); sq += __shfl_xor(sq, 8);
        const float rs = rsqrtf(sq * (1.0f / 128.0f) + EPS);
        const u32x4 z = __builtin_nontemporal_load((GAS const u32x4*)(UZ + (size_t)row * 1024 + ch * 8)); const f32x4 g0 = *(GAS const f32x4*)(cn + d0), g1 = *(GAS const f32x4*)(cn + d0 + 4);
        const float z0 = bf_lo(z.x), z1 = bf_hi(z.x), z2 = bf_lo(z.y), z3 = bf_hi(z.y), z4 = bf_lo(z.z), z5 = bf_hi(z.z), z6 = bf_lo(z.w), z7 = bf_hi(z.w);
        u32x4 pk;
        pk.x = pkbf(o0[0] * rs * g0[0] * (z0 * sigmoidf_(z0)), o0[1] * rs * g0[1] * (z1 * sigmoidf_(z1)));
        pk.y = pkbf(o0[2] * rs * g0[2] * (z2 * sigmoidf_(z2)), o0[3] * rs * g0[3] * (z3 * sigmoidf_(z3)));
        pk.z = pkbf(o1[0] * rs * g1[0] * (z4 * sigmoidf_(z4)), o1[1] * rs * g1[1] * (z5 * sigmoidf_(z5)));
        pk.w = pkbf(o1[2] * rs * g1[2] * (z6 * sigmoidf_(z6)), o1[3] * rs * g1[3] * (z7 * sigmoidf_(z7)));
        *(GAS u32x4*)(YC + (size_t)row * 1024 + ch * 8) = pk; }
}
__device__ __forceinline__ void phase_gates(const Args& a, int layer, int hf, LAS unsigned char* lds) {
    GAS unsigned char* ws = opq(a.ws); const size_t r0 = (size_t)hf * MH; const int G = gridDim.x, bid = blockIdx.x;
    pg8::StaticOrder S; S.init(MH, 3072, G, bid);
    pg8::Gemm gm{(const bf16_t*)(ws + WS_XB) + r0 * D_MODEL, (const bf16_t*)(ws + WS_WG), MH, 3072, D_MODEL};
    EpiGate E{(GAS bf16_t*)(ws + WS_GA), GP(a.b_in) + (size_t)layer * D_IN + N_MAIN, (GAS const float*)(ws + WS_SS) + ((size_t)(2 * layer) * M + r0) * 16};
    pg8::gemm_phase<EpiGate, pg8::StaticOrder, true, true>(lds, gm, S, E);
}
template <int WHICH> __device__ __forceinline__ void phase_br_one(const Args& a, int layer, int hf, LAS unsigned char* lds) {
    GAS unsigned char* ws = opq(a.ws); const int G = gridDim.x, bid = blockIdx.x;
    pg8::StaticOrder S; S.init(MH, D_MODEL, G, bid);
    GAS f32x4* mscr = (GAS f32x4*)(ws + WS_MSCR) + (size_t)bid * 32 * NTH; GAS bf16_t* MRG = (GAS bf16_t*)(ws + WS_MRG);
    const bf16_t* A = (const bf16_t*)(ws + (WHICH == 0 ? WS_YA : WHICH == 1 ? WS_YB : WS_YC)); const bf16_t* B = (const bf16_t*)(ws + (WHICH == 0 ? WS_WA : WHICH == 1 ? WS_WB : WS_WC));
    pg8::Gemm gm{A, B, MH, D_MODEL, WHICH == 2 ? 1024 : 512}; EpiBranch<WHICH> E{(GAS const bf16_t*)(ws + (WHICH == 0 ? WS_GA : WHICH == 1 ? WS_GB : WS_GC)), mscr, MRG}; pg8::gemm_phase<EpiBranch<WHICH>, pg8::StaticOrder, true, true>(lds, gm, S, E);
}
__device__ __forceinline__ void phase_wo(const Args& a, int layer, int hf, LAS unsigned char* lds) {
    GAS unsigned char* ws = opq(a.ws); const size_t r0 = (size_t)hf * MH; const int G = gridDim.x, bid = blockIdx.x;
    pg8::Gemm gm{(const bf16_t*)(ws + WS_MRG), (const bf16_t*)(ws + WS_WO), MH, D_MODEL, D_MODEL}; pg8::StaticOrder S; S.init(MH, D_MODEL, G, bid);
    GAS const float* base = (layer == 0) ? (GP(a.x) + r0 * D_MODEL) : (GP(a.out) + r0 * D_MODEL);
    EpiResid E{base, GP(a.out) + r0 * D_MODEL, (GAS bf16_t*)(ws + WS_XB) + r0 * D_MODEL, (GAS float*)(ws + WS_SS) + ((size_t)(2 * layer + 1) * M + r0) * 16};
    pg8::gemm_phase<EpiResid, pg8::StaticOrder, true, true>(lds, gm, S, E);
}
__device__ __forceinline__ void phase_ff1(const Args& a, int layer, LAS unsigned char* lds) {
    GAS unsigned char* ws = opq(a.ws); const int G = gridDim.x, bid = blockIdx.x;
    pg8::Gemm gm{(const bf16_t*)(ws + WS_XB), (const bf16_t*)(ws + WS_W1), M, D_FF, D_MODEL}; pg8::StaticOrder S; S.init(M, D_FF, G, bid);
#ifdef T_SKIP_BRWO
    EpiRelu2 E{(GAS bf16_t*)(ws + WS_H1), (GAS const float*)(ws + WS_SS) + (size_t)(2 * layer) * M * 16};
#else
    EpiRelu2 E{(GAS bf16_t*)(ws + WS_H1), (GAS const float*)(ws + WS_SS) + (size_t)(2 * layer + 1) * M * 16};
#endif
    pg8::gemm_phase<EpiRelu2, pg8::StaticOrder, true, true>(lds, gm, S, E);
}
__device__ __forceinline__ void phase_ff2(const Args& a, int layer, LAS unsigned char* lds) {
    GAS unsigned char* ws = opq(a.ws); const int G = gridDim.x, bid = blockIdx.x;
    pg8::Gemm gm{(const bf16_t*)(ws + WS_H1), (const bf16_t*)(ws + WS_W2), M, D_MODEL, D_FF}; pg8::StaticOrder S; S.init(M, D_MODEL, G, bid);
#ifdef T_SKIP_BRWO
    EpiResid E{(layer == 0) ? GP(a.x) : GP(a.out), GP(a.out), (GAS bf16_t*)(ws + WS_XB), (GAS float*)(ws + WS_SS) + (size_t)(2 * layer + 2) * M * 16};
#else
    EpiResid E{GP(a.out), GP(a.out), (GAS bf16_t*)(ws + WS_XB), (GAS float*)(ws + WS_SS) + (size_t)(2 * layer + 2) * M * 16};
#endif
 pg8::gemm_phase<EpiResid, pg8::StaticOrder, true, true>(lds, gm, S, E);
}
__device__ __forceinline__ void phase_final(const Args& a) {
    TIDS(); GAS unsigned char* ws = opq(a.ws); GAS const float* ssf = (GAS const float*)(ws + WS_SS) + (size_t)4 * M * 16;
    for (int e = gt; e < M * 256; e += ngt) { const int m = e >> 8, c4 = e & 255; const float rs = row_rstd(ssf, m);
        GAS f32x4* p = (GAS f32x4*)(GP(a.out) + (size_t)m * D_MODEL) + c4; const f32x4 gn = *((GAS const f32x4*)GP(a.norm_final) + c4); __builtin_nontemporal_store(__builtin_nontemporal_load(p) * rs * gn, p); }
}


#define XB_TMO      128
#define XB_XCNT(j)  (256  + 64 * (j))
#define XB_XSUB(j)  (1280 + 64 * (j))
#define XB_XGEN(j)  (2304 + 64 * (j))
#define XB_TOP      3328
#define XB_TOPGEN   3392
#define XCD_BAR_WORDS 3456
#define XB_SPIN_CAP (1u << 22)
__device__ __forceinline__ unsigned xb_ld(GAS unsigned* p)              { return __hip_atomic_load(p, __ATOMIC_RELAXED, __HIP_MEMORY_SCOPE_AGENT); }
__device__ __forceinline__ unsigned xb_add(GAS unsigned* p, unsigned v) { return __hip_atomic_fetch_add(p, v, __ATOMIC_RELAXED, __HIP_MEMORY_SCOPE_AGENT); }
__device__ __forceinline__ unsigned xb_xcc_id() { return (unsigned)__builtin_amdgcn_s_getreg((3 << 11) | 20) & 0xFu; }
#define XB_SPIN(cond, bar) do { unsigned _sp = 0; while (cond) { __builtin_amdgcn_s_sleep(1); \
    if ((++_sp & 255u) == 0u) { if (xb_ld(&(bar)[XB_TMO])) break; if (_sp > XB_SPIN_CAP) { xb_add(&(bar)[XB_TMO], 1u); break; } } } } while (0)
struct XcdBarrier { GAS unsigned* bar; unsigned x; volatile LAS unsigned* st; };
__device__ __forceinline__ XcdBarrier xcd_barrier_post(GAS unsigned* bar, volatile LAS unsigned* st) {
    XcdBarrier b; b.bar = bar; b.x = xb_xcc_id(); b.st = st;
    if (threadIdx.x == 0) (void)xb_add(&bar[XB_XCNT(b.x)], 1u);
    return b;
}
__device__ __forceinline__ void xcd_barrier_complete(GAS unsigned* bar, unsigned x, unsigned& nloc, unsigned& nx) {
    const unsigned G = gridDim.x * gridDim.y * gridDim.z;
    unsigned sum, cnt, mine, sp = 0u;
    for (;;) {
        sum = 0u; cnt = 0u; mine = 0u;
#pragma unroll
        for (unsigned j = 0; j < 16; ++j) { const unsigned c = xb_ld(&bar[XB_XCNT(j)]); sum += c; cnt += (c > 0u) ? 1u : 0u; mine = (j == x) ? c : mine; }
        if (sum == G) break;
        __builtin_amdgcn_s_sleep(1);
        if ((++sp & 255u) == 0u) { if (xb_ld(&bar[XB_TMO])) break; if (sp > XB_SPIN_CAP) { xb_add(&bar[XB_TMO], 1u); break; } }
    }
    nloc = mine > 0u ? mine : 1u; nx = cnt > 0u ? cnt : 1u;
}
__device__ __forceinline__ void xcd_barrier(const XcdBarrier& b) {
    asm volatile("s_waitcnt vmcnt(0)" ::: "memory");
    __syncthreads();
    if (threadIdx.x == 0) {
        GAS unsigned* bar = b.bar;
        __builtin_amdgcn_s_waitcnt(0);
        unsigned nloc = b.st[0], nx = b.st[1];
        if (nloc == 0u) { xcd_barrier_complete(bar, b.x, nloc, nx); b.st[0] = nloc; b.st[1] = nx; }
        const unsigned old = xb_add(&bar[XB_XSUB(b.x)], 1u);
        const unsigned gen = old / nloc;
        if (old + 1u == (gen + 1u) * nloc) {
            __builtin_amdgcn_fence(__ATOMIC_RELEASE, "agent");
            asm volatile("s_waitcnt vmcnt(0)" ::: "memory");
            const unsigned og = xb_add(&bar[XB_TOP], 1u);
            const unsigned tg = og / nx;
            if (og + 1u == (tg + 1u) * nx) xb_add(&bar[XB_TOPGEN], 1u);
            else XB_SPIN(xb_ld(&bar[XB_TOPGEN]) == tg, bar);
            __builtin_amdgcn_fence(__ATOMIC_ACQUIRE, "agent");
            xb_add(&bar[XB_XGEN(b.x)], 1u);
            asm volatile("s_waitcnt vmcnt(0)" ::: "memory");
        } else {
            XB_SPIN(xb_ld(&bar[XB_XGEN(b.x)]) == gen, bar);
            __builtin_amdgcn_fence(__ATOMIC_ACQUIRE, "agent");
            asm volatile("s_waitcnt vmcnt(0)" ::: "memory");
        }
    }
    __syncthreads();
}
__device__ __forceinline__ void gsync(cg::grid_group& grid) {
    asm volatile("s_waitcnt vmcnt(0) lgkmcnt(0)" ::: "memory");
    grid.sync();
    __builtin_amdgcn_fence(__ATOMIC_ACQUIRE, "agent");
    asm volatile("s_waitcnt vmcnt(0)" ::: "memory");
}
__global__ void __launch_bounds__(NTH, 2) mega_fwd(Args a) {
    extern __shared__ __attribute__((aligned(16))) unsigned char lds_raw[];
    LAS unsigned char* lds = (LAS unsigned char*)lds_raw;
    cg::grid_group grid = cg::this_grid();
    { volatile LAS unsigned* st = (volatile LAS unsigned*)(lds + LDS_CTL + 64); if (threadIdx.x < 2) st[threadIdx.x] = 0u; __syncthreads(); }
    const XcdBarrier xbar = xcd_barrier_post((GAS unsigned*)(opq(a.ws) + WS_CTL) + 4096, (volatile LAS unsigned*)(lds + LDS_CTL + 64));
#define XSYNC() xcd_barrier(xbar)
    phase_p0(a);
    for (int layer = 0; layer < DEPTH; ++layer) {
        for (int rep = 0; rep < REP_CONV; ++rep) phase_conv(a, layer, lds);
        gsync(grid);
        for (int hf = 0; hf < NSPLIT; ++hf) {
            for (int rep = 0; rep < REP_G1; ++rep) { phase_g1(a, layer, hf, lds); XSYNC(); }
            for (int rep = 0; rep < REP_MIX1; ++rep) { phase_mix(a, layer, hf, 0, lds, rep); XSYNC(); }
            for (int rep = 0; rep < REP_MIX2; ++rep) { phase_mix(a, layer, hf, 1, lds, rep); XSYNC(); }
            for (int rep = 0; rep < REP_POST; ++rep) { phase_post(a, layer); phase_gates(a, layer, hf, lds); XSYNC(); }
            for (int rep = 0; rep < REP_BR; ++rep) { phase_br_one<0>(a, layer, hf, lds); phase_br_one<1>(a, layer, hf, lds); phase_br_one<2>(a, layer, hf, lds); XSYNC(); }
            phase_wo(a, layer, hf, lds);
            XSYNC();
        }
        for (int rep = 1; rep < REP_FF1; ++rep) { phase_ff1(a, layer, lds); XSYNC(); }
        phase_ff1(a, layer, lds);
        XSYNC();
        phase_ff2(a, layer, lds);
        XSYNC();
    }
    phase_final(a);
}

extern "C" void kernel_launch(void* const* d_in, const int* in_sizes, int n_in, void* d_out, int out_size, void* d_ws, size_t ws_size, hipStream_t stream) {
    static int grid = 0;
    if (grid == 0) {
        if (n_in != 18 || out_size != M * D_MODEL || ws_size < WS_END) { fprintf(stderr, "kernel_launch: unexpected shapes: n_in %d out %d ws %zu\n", n_in, out_size, ws_size); grid = -1; return; }
        int dev = 0, cus = 0, per_cu = 0;
        hipGetDevice(&dev); hipDeviceGetAttribute(&cus, hipDeviceAttributeMultiprocessorCount, dev);
        if (hipFuncSetAttribute((const void*)mega_fwd, hipFuncAttributeMaxDynamicSharedMemorySize, LDS_BYTES) != hipSuccess) { fprintf(stderr, "kernel_launch: hipFuncSetAttribute failed\n"); grid = -1; return; }
        hipOccupancyMaxActiveBlocksPerMultiprocessor(&per_cu, (const void*)mega_fwd, NTH, LDS_BYTES);
        (void)hipGetLastError();
        if (per_cu < 1) per_cu = 1;
        grid = cus;
        fprintf(stderr, "kernel_launch: cus %d per_cu %d grid %d ws %zu\n", cus, per_cu, grid, ws_size);
    }
    if (grid < 0) return;
    hipMemsetAsync((char*)d_ws + WS_CTL, 0, CTL_BYTES, stream);
    Args a{};
    a.x = (const float*)d_in[0]; a.pos = (const int*)d_in[1]; a.norm_mix = (const float*)d_in[2]; a.w_in = (const float*)d_in[3]; a.b_in = (const float*)d_in[4];
    a.conv_w = (const float*)d_in[5]; a.a_log = (const float*)d_in[6]; a.dt_bias = (const float*)d_in[7]; a.sinks = (const float*)d_in[8]; a.c_norm = (const float*)d_in[9];
    a.wba = (const float*)d_in[10]; a.wbb = (const float*)d_in[11]; a.wbc = (const float*)d_in[12]; a.w_out = (const float*)d_in[13]; a.norm_ffn = (const float*)d_in[14];
    a.w_ff1 = (const float*)d_in[15]; a.w_ff2 = (const float*)d_in[16]; a.norm_final = (const float*)d_in[17]; a.out = (float*)d_out; a.ws = (unsigned char*)d_ws;
    void* args[] = {&a};
    hipError_t e = hipLaunchCooperativeKernel((const void*)mega_fwd, dim3(grid), dim3(NTH), args, LDS_BYTES, stream);
    if (e != hipSuccess) fprintf(stderr, "cooperative launch failed: %s (grid %d)\n", hipGetErrorString(e), grid);
}
```
